# Optimizing an MI355X kernel written in HIP

```python
import jax
import jax.numpy as jnp
from jax import lax
import numpy as np

D_MODEL = 1024
BATCH = 16
SEQ = 2048
DEPTH = 2

N_META = 16
CHUNK = 32
FRONT_PAD = (CHUNK - N_META % CHUNK) % CHUNK
F_TINY = 1e-30

GLA_HEADS = 4
GLA_DK = 64
GLA_DV = 128
GLA_K = GLA_HEADS * GLA_DK
GLA_V = GLA_HEADS * GLA_DV
GLA_GATE_RANK = 16
GLA_GATE_NORM = 16.0

RW_HEADS = 8
RW_HD = 64
RW_DIM = RW_HEADS * RW_HD
RW_W_RANK = 64
RW_A_RANK = 64
RW_V_RANK = 32
RW_G_RANK = 128
RW_GN_EPS = 64e-5

HG_HEADS = 4
HG_DK = 128
HG_DV = 128
HG_K = HG_HEADS * HG_DK
HG_V = HG_HEADS * HG_DV

D_FF = 2816
CONV_W = 3
NORM_EPS = 1e-6

GLA_LAYOUT = (("gla_q", GLA_K), ("gla_k", GLA_K), ("gla_v", GLA_V), ("gla_gk", GLA_GATE_RANK), ("gla_g", GLA_V))
HG_LAYOUT = (("hg_q", HG_K), ("hg_f", HG_K), ("hg_i", HG_V), ("hg_g", HG_V))
GATE_LAYOUT = (("gate_gla", D_MODEL), ("gate_rw", D_MODEL), ("gate_hg", D_MODEL))
NON_RW_LAYOUT = GLA_LAYOUT + HG_LAYOUT + GATE_LAYOUT
RW_LAYOUT = (("rw_r", RW_DIM), ("rw_w", RW_W_RANK), ("rw_k", RW_DIM), ("rw_v", RW_DIM), ("rw_a", RW_A_RANK), ("rw_g", RW_G_RANK))
RW_VRES_LAYOUT = (("rw_vr", RW_V_RANK),)
NON_RW = sum(w for _, w in NON_RW_LAYOUT)
RW_SHIFT = sum(w for _, w in RW_LAYOUT)
W_IN = NON_RW + RW_SHIFT

kernel_name = "hybrid_gla_rwkv7_hgrn2_block"


def _rmsnorm(x, w):
    x32 = x.astype(jnp.float32)
    y = x32 * lax.rsqrt(jnp.mean(x32 * x32, axis=-1, keepdims=True) + NORM_EPS)
    return (y * w.astype(jnp.float32)).astype(x.dtype)


def _head_rmsnorm(o, w):
    return o * lax.rsqrt(jnp.mean(o * o, axis=-1, keepdims=True) + NORM_EPS) * w


def _split(p, layout):
    out, off = {}, 0
    for name, width in layout:
        out[name] = p[..., off:off + width]
        off += width
    return out


def _token_shift(p, mu):
    prev = jnp.pad(p[:, :-1], ((0, 0), (1, 0), (0, 0)))
    return p + (prev - p) * mu.astype(p.dtype)


def _chunk_gated_linear_attention(q, k, v, g):
    bsz, t, h, dk = q.shape
    dv = v.shape[-1]
    pad = ((0, 0), (FRONT_PAD, 0), (0, 0), (0, 0))
    q, k, v, g = [jnp.pad(a, pad) for a in (q, k, v, g)]
    n = (t + FRONT_PAD) // CHUNK

    def blk(a):
        return a.reshape(bsz, n, CHUNK, h, a.shape[-1]).transpose(0, 3, 1, 2, 4)

    q, k, v, g = blk(q), blk(k), blk(v), blk(g)
    b = jnp.cumsum(g, axis=3)
    b_ref = b[:, :, :, CHUNK // 2 - 1:CHUNK // 2]
    b_last = b[:, :, :, -1:]
    scores = jnp.einsum('bhnid,bhnjd->bhnij', q * jnp.exp(b - b_ref), k * jnp.exp(b_ref - b))
    causal = jnp.tril(jnp.ones((CHUNK, CHUNK), dtype=bool))
    scores = jnp.where(causal, scores, 0.0)
    o_intra = jnp.einsum('bhnij,bhnjv->bhniv', scores, v)
    inc = jnp.einsum('bhnjd,bhnjv->bhndv', k * jnp.exp(b_last - b), v)
    dec = jnp.exp(b_last[:, :, :, 0])

    def step(s, xs):
        d_n, u_n = xs
        return d_n[..., None] * s + u_n, s

    s0 = jnp.zeros((bsz, h, dk, dv), jnp.float32)
    _, s_start = lax.scan(step, s0, (jnp.moveaxis(dec, 2, 0), jnp.moveaxis(inc, 2, 0)))
    s_start = jnp.moveaxis(s_start, 0, 2)
    o_inter = jnp.einsum('bhnid,bhndv->bhniv', q * jnp.exp(b), s_start)
    o = (o_intra + o_inter).transpose(0, 2, 3, 1, 4).reshape(bsz, n * CHUNK, h, dv)
    return o[:, FRONT_PAD:]


def _gla_branch(f, gk_up, gk_bias, norm_w):
    f32 = jnp.float32
    bsz, t, _ = f["gla_q"].shape
    q = f["gla_q"].astype(f32).reshape(bsz, t, GLA_HEADS, GLA_DK) * (GLA_DK ** -0.5)
    k = f["gla_k"].astype(f32).reshape(bsz, t, GLA_HEADS, GLA_DK)
    v = f["gla_v"].astype(f32).reshape(bsz, t, GLA_HEADS, GLA_DV)
    gk = jax.nn.log_sigmoid((f["gla_gk"] @ gk_up + gk_bias).astype(f32)) / GLA_GATE_NORM
    gk = gk.reshape(bsz, t, GLA_HEADS, GLA_DK)
    o = _chunk_gated_linear_attention(q, k, v, gk)
    g = f["gla_g"].astype(f32).reshape(bsz, t, GLA_HEADS, GLA_DV)
    o = _head_rmsnorm(o, norm_w.astype(f32)) * jax.nn.silu(g)
    return o.reshape(bsz, t, GLA_V)


def _hgrn2_branch(f, lb, norm_w):
    f32 = jnp.float32
    bsz, t, _ = f["hg_f"].shape
    z = f["hg_f"].astype(f32).reshape(bsz, t, HG_HEADS, HG_DK)
    lb = lb.reshape(HG_HEADS, HG_DK)
    forget = lb + (1.0 - lb) * jax.nn.sigmoid(z)
    log_f = jnp.log(jnp.maximum(forget, F_TINY))
    k = (1.0 - lb) * jax.nn.sigmoid(-z)
    q = f["hg_q"].astype(f32).reshape(bsz, t, HG_HEADS, HG_DK)
    i = f["hg_i"].astype(f32).reshape(bsz, t, HG_HEADS, HG_DV)
    o = _chunk_gated_linear_attention(q, k, i, log_f)
    g = f["hg_g"].astype(f32).reshape(bsz, t, HG_HEADS, HG_DV)
    o = _head_rmsnorm(o, norm_w.astype(f32)) * jax.nn.silu(g)
    return o.reshape(bsz, t, HG_V)


def _rwkv7_scan(r, w, k, v, kk, a):
    bsz, _, h, n = r.shape

    def step(s, xs):
        r_t, w_t, k_t, v_t, kk_t, a_t = xs
        sa = jnp.einsum('bhvk,bhk->bhv', s, -kk_t)
        s = (s * w_t[:, :, None, :] + sa[..., None] * (kk_t * a_t)[:, :, None, :]
             + v_t[..., None] * k_t[:, :, None, :])
        return s, jnp.einsum('bhvk,bhk->bhv', s, r_t)

    s0 = jnp.zeros((bsz, h, n, n), jnp.float32)
    xs = tuple(jnp.moveaxis(a_, 1, 0) for a_ in (r, w, k, v, kk, a))
    _, y = lax.scan(step, s0, xs)
    return jnp.moveaxis(y, 0, 1)


def _rwkv7_branch(s, w0, w2, a0, a2, g2, k_k, k_a, r_k, ln_w, ln_b, v_first, v0, v2):
    f32 = jnp.float32
    bsz, t, _ = s["rw_r"].shape
    r = s["rw_r"].astype(f32)
    k = s["rw_k"].astype(f32)
    v = s["rw_v"].astype(f32)
    w_log = -jax.nn.softplus(-(w0 + jnp.tanh(s["rw_w"]) @ w2).astype(f32)) - 0.5
    decay = jnp.exp(-jnp.exp(w_log))
    a = jax.nn.sigmoid((a0 + s["rw_a"] @ a2).astype(f32))
    g = (jax.nn.sigmoid(s["rw_g"]) @ g2).astype(f32)
    if v_first is None:
        v_first = v
    else:
        v = v + (v_first - v) * jax.nn.sigmoid((v0 + s["rw_vr"] @ v2).astype(f32))
    hd = lambda x_: x_.reshape(bsz, t, RW_HEADS, RW_HD)
    kk = hd(k * k_k.astype(f32))
    kk = kk / jnp.maximum(jnp.sqrt(jnp.sum(kk * kk, axis=-1, keepdims=True)), 1e-12)
    k = k * (1.0 + (a - 1.0) * k_a.astype(f32))
    rh, kh, vh = hd(r), hd(k), hd(v)
    y = _rwkv7_scan(rh, hd(decay), kh, vh, kk, hd(a))
    mean = jnp.mean(y, axis=-1, keepdims=True)
    var = jnp.mean(jnp.square(y - mean), axis=-1, keepdims=True)
    y = ((y - mean) * lax.rsqrt(var + RW_GN_EPS)).reshape(bsz, t, RW_DIM)
    y = y * ln_w.astype(f32) + ln_b.astype(f32)
    bonus = jnp.sum(rh * kh * r_k.astype(f32), axis=-1, keepdims=True) * vh
    y = (y + bonus.reshape(bsz, t, RW_DIM)) * g
    return y, v_first


def _conv_ffn(h, w_up, conv_w, conv_b, w_down):
    t = h.shape[1]
    u = h @ w_up
    up = jnp.pad(u, ((0, 0), (CONV_W - 1, 0), (0, 0)))
    c = conv_b + up[:, 0:t] * conv_w[0]
    for j in range(1, CONV_W):
        c = c + up[:, j:j + t] * conv_w[j]
    gate, val = c[..., :D_FF], c[..., D_FF:]
    return (jax.nn.silu(gate) * val) @ w_down


def setup_inputs(seed: int = 0) -> dict:
    key = jax.random.key(seed)
    ks = iter(jax.random.split(key, 40))
    nrm = lambda shape, scale: jax.random.normal(next(ks), shape, jnp.float32) * scale
    gain = lambda shape: 1.0 + nrm(shape, 0.02)
    uni = lambda shape, lo, hi: jax.random.uniform(next(ks), shape, jnp.float32, lo, hi)
    L = DEPTH
    return {
        "x": nrm((BATCH, SEQ, D_MODEL), 1.0),
        "meta": nrm((N_META, D_MODEL), 1.0),
        "mix_norm": gain((L, D_MODEL)),
        "w_in": nrm((L, D_MODEL, W_IN), D_MODEL ** -0.5),
        "w_in_vres": nrm((L - 1, D_MODEL, RW_V_RANK), D_MODEL ** -0.5),
        "rw_mu": uni((L, RW_SHIFT), 0.0, 1.0),
        "rw_mu_vres": uni((L - 1, RW_V_RANK), 0.0, 1.0),
        "gla_gk_up": nrm((L, GLA_GATE_RANK, GLA_K), GLA_GATE_RANK ** -0.5),
        "gla_gk_bias": nrm((L, GLA_K), 0.1),
        "gla_norm": gain((L, GLA_DV)),
        "rw_w0": uni((L, RW_DIM), -6.0, -1.0),
        "rw_w2": nrm((L, RW_W_RANK, RW_DIM), 0.1),
        "rw_a0": nrm((L, RW_DIM), 0.1),
        "rw_a2": nrm((L, RW_A_RANK, RW_DIM), 0.1),
        "rw_v0": nrm((L - 1, RW_DIM), 0.1),
        "rw_v2": nrm((L - 1, RW_V_RANK, RW_DIM), 0.1),
        "rw_g2": nrm((L, RW_G_RANK, RW_DIM), RW_G_RANK ** -0.5),
        "rw_kk": 0.85 + nrm((L, RW_DIM), 0.05),
        "rw_ka": 1.0 + nrm((L, RW_DIM), 0.05),
        "rw_rk": nrm((L, RW_HEADS, RW_HD), 0.1),
        "rw_ln_w": gain((L, RW_DIM)),
        "rw_ln_b": nrm((L, RW_DIM), 0.02),
        "hg_lb_logits": nrm((L, HG_K), 0.1),
        "hg_norm": gain((L, HG_DV)),
        "w_out_gla": nrm((L, GLA_V, D_MODEL), GLA_V ** -0.5),
        "w_out_rw": nrm((L, RW_DIM, D_MODEL), RW_DIM ** -0.5),
        "w_out_hg": nrm((L, HG_V, D_MODEL), HG_V ** -0.5),
        "w_out": nrm((L, D_MODEL, D_MODEL), D_MODEL ** -0.5),
        "ffn_norm": gain((L, D_MODEL)),
        "w_up": nrm((L, D_MODEL, 2 * D_FF), D_MODEL ** -0.5),
        "conv_w": nrm((L, CONV_W, 2 * D_FF), CONV_W ** -0.5),
        "conv_b": nrm((L, 2 * D_FF), 0.02),
        "w_down": nrm((L, D_FF, D_MODEL), D_FF ** -0.5),
        "final_norm": gain((D_MODEL,)),
    }


def reference(x, meta, mix_norm, w_in, w_in_vres, rw_mu, rw_mu_vres, gla_gk_up, gla_gk_bias, gla_norm,
              rw_w0, rw_w2, rw_a0, rw_a2, rw_v0, rw_v2, rw_g2, rw_kk, rw_ka, rw_rk, rw_ln_w, rw_ln_b,
              hg_lb_logits, hg_norm, w_out_gla, w_out_rw, w_out_hg, w_out, ffn_norm, w_up, conv_w, conv_b,
              w_down, final_norm):
    bsz = x.shape[0]
    dt = x.dtype
    z = jnp.concatenate([jnp.broadcast_to(meta.astype(dt)[None], (bsz, N_META, D_MODEL)), x], axis=1)
    lb_p = jax.nn.softmax(hg_lb_logits.astype(jnp.float32), axis=0)
    lb_all = jnp.cumsum(lb_p, axis=0) - lb_p[0:1]
    v_first = None
    for i in range(DEPTH):
        h = _rmsnorm(z, mix_norm[i])
        if i == 0:
            w_cat, mu, rw_layout, v0_i, v2_i = w_in[0], rw_mu[0], RW_LAYOUT, None, None
        else:
            w_cat = jnp.concatenate([w_in[i], w_in_vres[i - 1]], axis=1)
            mu = jnp.concatenate([rw_mu[i], rw_mu_vres[i - 1]], axis=0)
            rw_layout, v0_i, v2_i = RW_LAYOUT + RW_VRES_LAYOUT, rw_v0[i - 1], rw_v2[i - 1]
        p = h @ w_cat
        f = _split(p[..., :NON_RW], NON_RW_LAYOUT)
        s = _split(_token_shift(p[..., NON_RW:], mu), rw_layout)
        y_gla = _gla_branch(f, gla_gk_up[i], gla_gk_bias[i], gla_norm[i]).astype(dt)
        y_rw, v_first = _rwkv7_branch(s, rw_w0[i], rw_w2[i], rw_a0[i], rw_a2[i], rw_g2[i], rw_kk[i], rw_ka[i],
                                      rw_rk[i], rw_ln_w[i], rw_ln_b[i], v_first, v0_i, v2_i)
        y_hg = _hgrn2_branch(f, lb_all[i], hg_norm[i]).astype(dt)
        merged = (jax.nn.sigmoid(f["gate_gla"]) * (y_gla @ w_out_gla[i])
                  + jax.nn.sigmoid(f["gate_rw"]) * (y_rw.astype(dt) @ w_out_rw[i])
                  + jax.nn.sigmoid(f["gate_hg"]) * (y_hg @ w_out_hg[i]))
        z = z + merged @ w_out[i]
        z = z + _conv_ffn(_rmsnorm(z, ffn_norm[i]), w_up[i], conv_w[i], conv_b[i], w_down[i])
    return _rmsnorm(z, final_norm)[:, N_META:]
```

```cpp
#include <hip/hip_runtime.h>
#include <hip/hip_cooperative_groups.h>
#include <cstdio>
#include <cstdint>
namespace cg = cooperative_groups;

#define LAS __attribute__((address_space(3)))
typedef unsigned short bf16_t;
typedef short bf16x8 __attribute__((ext_vector_type(8)));
typedef short bf16x4 __attribute__((ext_vector_type(4)));
typedef float f32x4 __attribute__((ext_vector_type(4)));
typedef unsigned u32x4 __attribute__((ext_vector_type(4)));
typedef unsigned u32x2 __attribute__((ext_vector_type(2)));

constexpr int NB = 16, TS = 2064, MROWS = NB * TS  , DM = 1024, LDP = 5424, DFF = 2816;
constexpr int NTHR = 512;
constexpr int PC_GQ = 0, PC_GK = 256, PC_GV = 512, PC_GG = 1024, PC_HQ = 1536, PC_HF = 2048, PC_HI = 2560, PC_HG = 3072,
              PC_RR = 3584, PC_RK = 4096, PC_RV = 4608, PC_RW = 5120, PC_RA = 5184, PC_RG = 5248, PC_RVR = 5376, PC_GGK = 5408;
constexpr size_t WS_Z = 65536;
constexpr size_t WS_P = WS_Z + (size_t)MROWS * DM * 4;
constexpr size_t WS_WB = WS_P + (size_t)MROWS * LDP * 2;
constexpr size_t WB_WIN = 0, WB_WG = 11534336, WB_WO = 17825792, WB_WOUT = 20971520, WB_WUP = 23068672, WB_WDN = 34603008, WB_END = 40370176;
static_assert(WS_WB + WB_END <= 536870912ull, "ws map");
constexpr size_t DO_H = 4096, DO_VF = 68157440;
constexpr int LDS_BYTES = 147456;
constexpr int LDS_XCH = 131072;

struct Args { const float* in[34]; float* out; unsigned char* ws; };

__device__ __forceinline__ unsigned f2bf(float f) { unsigned u = __builtin_bit_cast(unsigned, f); return (u + 0x7fffu + ((u >> 16) & 1u)) >> 16; }
__device__ __forceinline__ unsigned pk2(float lo, float hi) { unsigned r; asm("v_cvt_pk_bf16_f32 %0, %1, %2" : "=v"(r) : "v"(lo), "v"(hi)); return r; }
__device__ __forceinline__ float bf2f(unsigned short h) { return __builtin_bit_cast(float, (unsigned)h << 16); }
__device__ __forceinline__ float bflo(unsigned w) { return __builtin_bit_cast(float, w << 16); }
__device__ __forceinline__ float bfhi(unsigned w) { return __builtin_bit_cast(float, w & 0xffff0000u); }
__device__ __forceinline__ float sigmoidf_(float x) { return 1.0f / (1.0f + __expf(-x)); }
__device__ __forceinline__ float softplusf_(float x) { return fmaxf(x, 0.f) + log1pf(__expf(-fabsf(x))); }
__device__ __forceinline__ float tanhf_(float x) { float e = __expf(2.0f * x); return 1.0f - 2.0f / (e + 1.0f); }
template <int CTRL> __device__ __forceinline__ float dppf(float x) {
    return __builtin_bit_cast(float, __builtin_amdgcn_update_dpp(0, __builtin_bit_cast(int, x), CTRL, 0xf, 0xf, true));
}
__device__ __forceinline__ float red8(float x) { x += dppf<0xB1>(x); x += dppf<0x4E>(x); x += dppf<0x141>(x); return x; }
__device__ __forceinline__ float red16(float x) { x = red8(x); x += dppf<0x140>(x); return x; }
__device__ __forceinline__ float wave_sum(float v) {
#pragma unroll
    for (int o = 32; o > 0; o >>= 1) v += __shfl_xor(v, o, 64);
    return v;
}
#define LDS_WAIT() asm volatile("s_waitcnt lgkmcnt(0)" ::: "memory")
#define WG_BAR() do { asm volatile("s_waitcnt lgkmcnt(0)" ::: "memory"); __builtin_amdgcn_s_barrier(); asm volatile("" ::: "memory"); } while (0)

namespace pg {
constexpr int BM = 256, BK = 64, HALF = 128, HTB = HALF * BK * 2, STAGE_BYTES = 8 * HTB, NXCD = 8, WGM = 8;
__host__ __device__ __forceinline__ int lds_byte(int r, int c) { const int st = (r >> 4) * 2 + (c >> 5), rr = r & 15, cc = c & 31, ob = rr * 64 + cc * 2; return st * 1024 + (ob ^ (((ob >> 9) & 1) << 5)); }
__host__ __device__ __forceinline__ void stage_rc(int b, int& R, int& C) { const int st = b / 1024, sb = b % 1024, swz = sb ^ (((sb >> 9) & 1) << 5); R = (st >> 1) * 16 + swz / 64; C = (st & 1) * 32 + (swz % 64) / 2; }
__host__ __device__ __forceinline__ int perm32(int rho) { const int n = rho >> 4, i = rho & 15; return 8 * (i >> 2) + 4 * n + (i & 3); }

struct Unit { int pm, pn, aux; };

struct Order2D {
    int nM, nN, nwg, G, c, rep;
    __device__ void init(int nM_, int nN_, int G_, int c_, int rep_ = 1) { nM = nM_; nN = nN_; nwg = nM * nN; G = G_; c = c_; rep = rep_; }
    __device__ bool next(int i, Unit& u) const {
        const int ti = i / rep; u.aux = i - ti * rep;
        const long L = (long)ti * G + c; if (L >= nwg) return false;
        int wgid = (int)L; { const int q = nwg / NXCD, r = nwg % NXCD, xcd = wgid % NXCD, off = wgid / NXCD; wgid = (xcd < r ? xcd * (q + 1) : r * (q + 1) + (xcd - r) * q) + off; }
        const int nig = WGM * nN, gid = wgid / nig, fm = gid * WGM, gsz = (nM - fm) < WGM ? (nM - fm) : WGM;
        u.pm = fm + ((wgid % nig) % gsz); u.pn = (wgid % nig) / gsz; return true;
    }
};

template <class Epi, class G, class Sched>
__device__ __forceinline__ void gemm_phase(LAS unsigned char* lds, const G g, const Sched& S, const Epi& E) {
    int tid; asm volatile("v_mov_b32 %0, %1" : "=v"(tid) : "v"((int)threadIdx.x));
    const int wid = __builtin_amdgcn_readfirstlane(tid >> 6), lane = tid & 63, wr = wid >> 2, wc = wid & 3, fr = lane & 15, fq = lane >> 4;
    const int K = g.K, nt = K / BK;
    unsigned voffA[2], voffB[2];
#pragma unroll
    for (int i = 0; i < 2; ++i) { int R, C; stage_rc(tid * 16 + i * 8192, R, C); const int Rb = Epi::PERM ? ((R & ~31) + perm32(R & 31)) : R;
        voffA[i] = (unsigned)(R * g.lda + C) * 2u; voffB[i] = (unsigned)(Rb * g.ldb + C) * 2u; }
    const size_t kstep = (size_t)(BK * 2);
    const size_t hstepA = (size_t)HALF * g.lda * 2, hstepB = (size_t)HALF * g.ldb * 2;
    const unsigned ldsw = (unsigned)wid * 1024u;
    const int aoff = lds_byte(wr * 64 + fr, fq * 8), boff = lds_byte(wc * 32 + fr, fq * 8);
#define PG_SA(b, h) (((b) * 2 + (h)) * HTB)
#define PG_SB(b, h) ((4 + (b) * 2 + (h)) * HTB)
#define PG_STAGE(bufoff, gbase, voff) do { _Pragma("unroll") for (int _i = 0; _i < 2; ++_i) \
        __builtin_amdgcn_global_load_lds((const unsigned*)((const char*)(gbase) + (voff)[_i]), (LAS unsigned*)(lds + (bufoff) + ldsw + _i * 8192), 16, 0, 0); } while (0)
#define PG_LDA(dst, b, h) do { _Pragma("unroll") for (int m = 0; m < 4; ++m) _Pragma("unroll") for (int k = 0; k < 2; ++k) dst[m][k] = *(const LAS bf16x8*)(lds + PG_SA(b, h) + aoff + m * 2048 + k * 1024); } while (0)
#define PG_LDB(dst, b, h) do { _Pragma("unroll") for (int n = 0; n < 2; ++n) _Pragma("unroll") for (int k = 0; k < 2; ++k) dst[n][k] = *(const LAS bf16x8*)(lds + PG_SB(b, h) + boff + n * 2048 + k * 1024); } while (0)
#define PG_MMA(ai, bj, At, Bt) do { __builtin_amdgcn_s_setprio(1); _Pragma("unroll") for (int m = 0; m < 4; ++m) _Pragma("unroll") for (int n = 0; n < 2; ++n) _Pragma("unroll") for (int k = 0; k < 2; ++k) \
        acc[ai][bj][m][n] = __builtin_amdgcn_mfma_f32_16x16x32_bf16(Bt[n][k], At[m][k], acc[ai][bj][m][n], 0, 0, 0); __builtin_amdgcn_s_setprio(0); } while (0)
#define PG_WAIT_V(n) asm volatile("s_waitcnt vmcnt(" #n ")" ::: "memory")
#define PG_WAIT_L(n) asm volatile("s_waitcnt lgkmcnt(" #n ")" ::: "memory")
#define PG_BAR __builtin_amdgcn_s_barrier()
#define PG_SCHED __builtin_amdgcn_sched_barrier(0)
    Unit cur, nxt; int ui = 0;
    if (!S.next(0, cur)) return;
    f32x4 acc[2][2][4][2];
#pragma unroll
    for (int a = 0; a < 2; ++a)
#pragma unroll
        for (int b = 0; b < 2; ++b)
#pragma unroll
            for (int m = 0; m < 4; ++m)
#pragma unroll
                for (int n = 0; n < 2; ++n) acc[a][b][m][n] = (f32x4){0.f, 0.f, 0.f, 0.f};
    bf16x8 At[4][2], B0[2][2], B1[2][2];
    const char* cA = g.a(cur); const char* cB = g.b(cur);
    PG_STAGE(PG_SB(0, 0), cB, voffB); PG_STAGE(PG_SB(0, 1), cB + hstepB, voffB); PG_STAGE(PG_SA(0, 0), cA, voffA); PG_STAGE(PG_SA(0, 1), cA + hstepA, voffA);
    if (wr == 1) PG_BAR;
    PG_WAIT_V(2); PG_BAR;
    PG_STAGE(PG_SB(1, 0), cB + kstep, voffB); PG_STAGE(PG_SA(1, 0), cA + kstep, voffA); PG_STAGE(PG_SB(1, 1), cB + hstepB + kstep, voffB);
    PG_WAIT_V(6); PG_BAR;
    for (;;) {
        const bool has_next = S.next(ui + 1, nxt);
        const char* nA = has_next ? g.a(nxt) : cA; const char* nB = has_next ? g.b(nxt) : cB;
        for (int t = 0; t < nt; t += 2) {
            const bool last = (t == nt - 2);
            const char* a1 = cA + (size_t)(t + 1) * kstep;
            const char* a2 = last ? nA : cA + (size_t)(t + 2) * kstep; const char* b2 = last ? nB : cB + (size_t)(t + 2) * kstep;
            const char* a3 = a2 + kstep; const char* b3 = b2 + kstep;
            PG_LDB(B0, 0, 0); PG_LDB(B1, 0, 1); PG_SCHED; PG_LDA(At, 0, 0); PG_STAGE(PG_SA(1, 1), a1 + hstepA, voffA);
            PG_WAIT_V(8); PG_WAIT_L(0); PG_BAR; PG_MMA(0, 0, At, B0); PG_MMA(0, 1, At, B1); PG_BAR; PG_SCHED;
            PG_LDA(At, 0, 1); PG_STAGE(PG_SB(0, 0), b2, voffB); PG_STAGE(PG_SB(0, 1), b2 + hstepB, voffB); PG_STAGE(PG_SA(0, 0), a2, voffA);
            PG_WAIT_V(8); PG_WAIT_L(0); PG_BAR; PG_MMA(1, 0, At, B0); PG_MMA(1, 1, At, B1); PG_BAR; PG_SCHED;
            PG_LDB(B0, 1, 0); PG_LDB(B1, 1, 1); PG_SCHED; PG_LDA(At, 1, 0); PG_STAGE(PG_SA(0, 1), a2 + hstepA, voffA);
            PG_WAIT_V(8); PG_WAIT_L(0); PG_BAR; PG_MMA(0, 0, At, B0); PG_MMA(0, 1, At, B1); PG_BAR; PG_SCHED;
            PG_LDA(At, 1, 1); PG_STAGE(PG_SB(1, 0), b3, voffB); PG_STAGE(PG_SB(1, 1), b3 + hstepB, voffB); PG_STAGE(PG_SA(1, 0), a3, voffA);
            PG_WAIT_V(8); PG_WAIT_L(0); PG_BAR; PG_MMA(1, 0, At, B0); PG_MMA(1, 1, At, B1); PG_BAR; PG_SCHED;
        }
        if (wr == 0) PG_BAR;
        { int te; asm volatile("v_mov_b32 %0, %1" : "=v"(te) : "v"((int)threadIdx.x)); const int le = te & 63; E(acc, cur, wr, wc, le & 15, le >> 4, lds); }
        if (!has_next) break;
#pragma unroll
        for (int a = 0; a < 2; ++a)
#pragma unroll
            for (int b = 0; b < 2; ++b)
#pragma unroll
                for (int m = 0; m < 4; ++m)
#pragma unroll
                    for (int n = 0; n < 2; ++n) acc[a][b][m][n] = (f32x4){0.f, 0.f, 0.f, 0.f};
        cur = nxt; cA = nA; cB = nB; ++ui;
        if (wr == 1) PG_BAR;
    }
    PG_WAIT_V(0);
    PG_BAR;
#undef PG_SA
#undef PG_SB
#undef PG_STAGE
#undef PG_LDA
#undef PG_LDB
#undef PG_MMA
#undef PG_WAIT_V
#undef PG_WAIT_L
#undef PG_BAR
#undef PG_SCHED
}

struct GemmPlain { const bf16_t* A; const bf16_t* Bt; int lda, ldb, K;
    __device__ __forceinline__ const char* a(const Unit& u) const { return (const char*)(A + (size_t)u.pm * 256 * lda); }
    __device__ __forceinline__ const char* b(const Unit& u) const { return (const char*)(Bt + (size_t)u.pn * 256 * ldb); } };
struct GemmMerge { const bf16_t* P; const bf16_t* Wo; int lda, ldb, K;
    __device__ __forceinline__ const char* a(const Unit& u) const { const int yc = u.aux == 0 ? PC_GG : (u.aux == 1 ? PC_RR : PC_HG); return (const char*)(P + (size_t)u.pm * 256 * LDP + yc); }
    __device__ __forceinline__ const char* b(const Unit& u) const { return (const char*)(Wo + (size_t)u.aux * 1024 * 512 + (size_t)u.pn * 256 * 512); } };
struct GemmUp { const bf16_t* H; const bf16_t* Bt; int lda, ldb, K;
    __device__ __forceinline__ const char* a(const Unit& u) const { return (const char*)(H + ((long)u.pm * 254 - 2) * 1024); }
    __device__ __forceinline__ const char* b(const Unit& u) const { return (const char*)(Bt + (size_t)u.pn * 256 * 1024); } };

__device__ __forceinline__ int gmap(int j) { return j < 4 ? 256 * j : (j < 10 ? 1536 + 256 * (j - 4) : 4096 + 256 * (j - 10)); }

struct EpiP {
    static constexpr bool PERM = true; bf16_t* P;
    __device__ __forceinline__ void operator()(const f32x4 (&acc)[2][2][4][2], const Unit& u, int wr, int wc, int fr, int fq, LAS unsigned char*) const {
        const int row0 = u.pm * 256 + wr * 64 + fr, col0 = u.pn * 256 + wc * 32 + 8 * fq;
#pragma unroll
        for (int ai = 0; ai < 2; ++ai)
#pragma unroll
            for (int m = 0; m < 4; ++m) { bf16_t* rowp = P + (size_t)(row0 + ai * 128 + m * 16) * LDP;
#pragma unroll
                for (int bj = 0; bj < 2; ++bj) { const int col = col0 + bj * 128; if (col < LDP) { const f32x4 v0 = acc[ai][bj][m][0], v1 = acc[ai][bj][m][1];
                    u32x4 w; w.x = pk2(v0[0], v0[1]); w.y = pk2(v0[2], v0[3]); w.z = pk2(v1[0], v1[1]); w.w = pk2(v1[2], v1[3]); *(u32x4*)(rowp + col) = w; } } }
    }
};
struct EpiGate {
    static constexpr bool PERM = true; bf16_t* P;
    __device__ __forceinline__ void operator()(const f32x4 (&acc)[2][2][4][2], const Unit& u, int wr, int wc, int fr, int fq, LAS unsigned char*) const {
        const int row0 = u.pm * 256 + wr * 64 + fr, col0 = gmap(u.pn) + wc * 32 + 8 * fq;
#pragma unroll
        for (int ai = 0; ai < 2; ++ai)
#pragma unroll
            for (int m = 0; m < 4; ++m) { bf16_t* rowp = P + (size_t)(row0 + ai * 128 + m * 16) * LDP + col0;
#pragma unroll
                for (int bj = 0; bj < 2; ++bj) { const f32x4 v0 = acc[ai][bj][m][0], v1 = acc[ai][bj][m][1];
                    u32x4 w; w.x = pk2(sigmoidf_(v0[0]), sigmoidf_(v0[1])); w.y = pk2(sigmoidf_(v0[2]), sigmoidf_(v0[3]));
                    w.z = pk2(sigmoidf_(v1[0]), sigmoidf_(v1[1])); w.w = pk2(sigmoidf_(v1[2]), sigmoidf_(v1[3])); *(u32x4*)(rowp + bj * 128) = w; } }
    }
};
struct EpiMerge {
    static constexpr bool PERM = true; const bf16_t* P; bf16_t* Mg;
    __device__ __forceinline__ void operator()(const f32x4 (&acc)[2][2][4][2], const Unit& u, int wr, int wc, int fr, int fq, LAS unsigned char*) const {
        const int row0 = u.pm * 256 + wr * 64 + fr, cin = wc * 32 + 8 * fq, br = u.aux;
        const int gcol = gmap(4 * br + u.pn) + cin, mcol = u.pn * 256 + cin;
#pragma unroll
        for (int ai = 0; ai < 2; ++ai)
#pragma unroll
            for (int m = 0; m < 4; ++m) { const size_t row = (size_t)(row0 + ai * 128 + m * 16);
#pragma unroll
                for (int bj = 0; bj < 2; ++bj) { const f32x4 v0 = acc[ai][bj][m][0], v1 = acc[ai][bj][m][1];
                    const u32x4 gw = *(const u32x4*)(P + row * LDP + gcol + bj * 128);
                    float r[8] = { bflo(gw.x) * v0[0], bfhi(gw.x) * v0[1], bflo(gw.y) * v0[2], bfhi(gw.y) * v0[3], bflo(gw.z) * v1[0], bfhi(gw.z) * v1[1], bflo(gw.w) * v1[2], bfhi(gw.w) * v1[3] };
                    bf16_t* mp = Mg + row * 1024 + mcol + bj * 128;
                    if (br > 0) { const u32x4 pw = *(const u32x4*)mp; r[0] += bflo(pw.x); r[1] += bfhi(pw.x); r[2] += bflo(pw.y); r[3] += bfhi(pw.y); r[4] += bflo(pw.z); r[5] += bfhi(pw.z); r[6] += bflo(pw.w); r[7] += bfhi(pw.w); }
                    u32x4 w; w.x = pk2(r[0], r[1]); w.y = pk2(r[2], r[3]); w.z = pk2(r[4], r[5]); w.w = pk2(r[6], r[7]); *(u32x4*)mp = w; } }
    }
};
struct EpiResid {
    static constexpr bool PERM = false; float* Z;
    __device__ __forceinline__ void operator()(const f32x4 (&acc)[2][2][4][2], const Unit& u, int wr, int wc, int fr, int fq, LAS unsigned char*) const {
        const int row0 = u.pm * 256 + wr * 64 + fr, col0 = u.pn * 256 + wc * 32 + 4 * fq;
#pragma unroll
        for (int ai = 0; ai < 2; ++ai)
#pragma unroll
            for (int m = 0; m < 4; ++m) { float* rowp = Z + (size_t)(row0 + ai * 128 + m * 16) * 1024 + col0;
#pragma unroll
                for (int bj = 0; bj < 2; ++bj)
#pragma unroll
                    for (int n = 0; n < 2; ++n) { f32x4* p = (f32x4*)(rowp + bj * 128 + n * 16); *p = *p + acc[ai][bj][m][n]; } }
    }
};
struct EpiFFN {
    static constexpr bool PERM = true; bf16_t* Act; const float* cw; const float* cb;
    __device__ __forceinline__ void operator()(f32x4 (&acc)[2][2][4][2], const Unit& u, int wr, int wc, int fr, int fq, LAS unsigned char* lds) const {
        LAS float* xch = (LAS float*)(lds + LDS_XCH);
        const int ccol = wc * 32 + 8 * fq;
        if (fr >= 14) {
#pragma unroll
            for (int ai = 0; ai < 2; ++ai)
#pragma unroll
                for (int bj = 0; bj < 2; ++bj)
#pragma unroll
                    for (int n = 0; n < 2; ++n) *(LAS f32x4*)(xch + ((2 * ai + wr) * 2 + (fr - 14)) * 256 + bj * 128 + ccol + 4 * n) = acc[ai][bj][3][n];
        }
        WG_BAR();
        const int ffbase = u.pn * 128 + ccol;
        const int Rbase = u.pm * 254 - 2 + wr * 64 + fr;
        unsigned mk0 = 0u, mk1 = 0u;
#pragma unroll
        for (int ai = 0; ai < 2; ++ai)
#pragma unroll
            for (int m = 0; m < 4; ++m) { const int tm = (Rbase + ai * 128 + m * 16 + TS) % TS; mk0 |= (tm == 0 ? 1u : 0u) << (4 * ai + m); mk1 |= (tm < 2 ? 1u : 0u) << (4 * ai + m); }
        const bool f0 = fr == 0, f1 = fr == 1;
#pragma unroll
        for (int n = 0; n < 2; ++n)
#pragma unroll
            for (int e = 0; e < 4; ++e) {
                float cres[2][2][4];
#pragma unroll
                for (int bj = 0; bj < 2; ++bj) {
                    const int cc = bj * DFF + ffbase + 4 * n + e;
                    float w0 = cw[cc], w1 = cw[2 * DFF + cc], w2 = cw[4 * DFF + cc], bb = cb[cc];
                    asm volatile("" : "+v"(w0), "+v"(w1), "+v"(w2), "+v"(bb));
#pragma unroll
                    for (int ai = 0; ai < 2; ++ai) {
                        const int seg = 2 * ai + wr, sp = seg > 0 ? seg - 1 : 0;
                        float h0 = xch[(sp * 2 + 0) * 256 + bj * 128 + ccol + 4 * n + e], h1 = xch[(sp * 2 + 1) * 256 + bj * 128 + ccol + 4 * n + e];
                        h0 = seg > 0 ? h0 : 0.f; h1 = seg > 0 ? h1 : 0.f;
                        float a1p = 0.f, a2p = 0.f;
#pragma unroll
                        for (int m = 0; m < 4; ++m) {
                            float uu = acc[ai][bj][m][n][e];
                            asm volatile("" : "+v"(uu));
                            const float a1 = dppf<0x121>(uu), a2 = dppf<0x122>(uu);
                            float p1, p2;
                            if (m == 0) { p1 = f0 ? h1 : a1; p2 = f0 ? h0 : (f1 ? h1 : a2); }
                            else { p1 = f0 ? a1p : a1; p2 = (f0 || f1) ? a2p : a2; }
                            a1p = a1; a2p = a2;
                            p1 = ((mk0 >> (4 * ai + m)) & 1u) ? 0.f : p1; p2 = ((mk1 >> (4 * ai + m)) & 1u) ? 0.f : p2;
                            cres[bj][ai][m] = bb + w0 * p2 + w1 * p1 + w2 * uu;
                        }
                    }
                }
#pragma unroll
                for (int ai = 0; ai < 2; ++ai)
#pragma unroll
                    for (int m = 0; m < 4; ++m) { const float gt = cres[0][ai][m]; float rr = gt * sigmoidf_(gt) * cres[1][ai][m]; asm volatile("" : "+v"(rr)); acc[ai][0][m][n][e] = rr; }
            }
#pragma unroll
        for (int ai = 0; ai < 2; ++ai)
#pragma unroll
            for (int m = 0; m < 4; ++m) {
                const int rl = ai * 128 + wr * 64 + m * 16 + fr; const int R = u.pm * 254 - 2 + rl;
                if (rl >= 2 && R < MROWS) { const f32x4 v0 = acc[ai][0][m][0], v1 = acc[ai][0][m][1];
                    u32x4 w; w.x = pk2(v0[0], v0[1]); w.y = pk2(v0[2], v0[3]); w.z = pk2(v1[0], v1[1]); w.w = pk2(v1[2], v1[3]); *(u32x4*)(Act + (size_t)R * DFF + ffbase) = w; }
            }
    }
};
}

__device__ __forceinline__ void cvt_seg(const float* __restrict__ src, int ldsrc, int col0, bf16_t* __restrict__ dst, int K, int row0, int ncols, int mode, float* tile) {
    int tid; asm volatile("v_mov_b32 %0, %1" : "=v"(tid) : "v"((int)threadIdx.x));
    const int nkt = K / 64, njt = (ncols + 63) / 64, nit = nkt * njt;
    for (int it = blockIdx.x; it < nit; it += gridDim.x) {
        const int kt = it % nkt, jt = it / nkt, kb = kt * 64, jb = jt * 64;
        int sb = col0 + jb;
        if (mode == 1) { const int pn = jb >> 8, j = jb & 255; sb = (j < 128) ? 128 * pn + j : DFF + 128 * pn + (j - 128); }
        { const int j = tid & 63, k0 = tid >> 6;
#pragma unroll
          for (int p = 0; p < 8; ++p) { const int k = k0 + 8 * p; float v = 0.f; if (jb + j < ncols) v = src[(size_t)(kb + k) * ldsrc + sb + j]; tile[k * 65 + j] = v; } }
        __syncthreads();
        { const int jj = tid >> 3, kg = tid & 7;
          if (jb + jj < ncols) { u32x4 w; const float* tp = tile + (8 * kg) * 65 + jj;
              w.x = pk2(tp[0], tp[65]); w.y = pk2(tp[130], tp[195]); w.z = pk2(tp[260], tp[325]); w.w = pk2(tp[390], tp[455]);
              *(u32x4*)(dst + (size_t)(row0 + jb + jj) * K + kb + 8 * kg) = w; } }
        __syncthreads();
    }
}
__device__ __forceinline__ void convert_weights(const Args& a, int l, unsigned char* wb, float* tile) {
    const float* win = a.in[3] + (size_t)l * 1024 * 8464;
    bf16_t* WIN = (bf16_t*)(wb + WB_WIN);
    cvt_seg(win, 8464, 0, WIN, 1024, 0, 1024, 0, tile);
    cvt_seg(win, 8464, 1040, WIN, 1024, 1024, 512, 0, tile);
    cvt_seg(win, 8464, 1552, WIN, 1024, 1536, 2048, 0, tile);
    cvt_seg(win, 8464, 6672, WIN, 1024, 3584, 512, 0, tile);
    cvt_seg(win, 8464, 7248, WIN, 1024, 4096, 1024, 0, tile);
    cvt_seg(win, 8464, 7184, WIN, 1024, 5120, 64, 0, tile);
    cvt_seg(win, 8464, 8272, WIN, 1024, 5184, 192, 0, tile);
    if (l == 1) cvt_seg(a.in[4], 32, 0, WIN, 1024, 5376, 32, 0, tile);
    cvt_seg(win, 8464, 1024, WIN, 1024, 5408, 16, 0, tile);
    cvt_seg(win, 8464, 3600, (bf16_t*)(wb + WB_WG), 1024, 0, 3072, 0, tile);
    cvt_seg(a.in[24] + (size_t)l * 512 * 1024, 1024, 0, (bf16_t*)(wb + WB_WO), 512, 0, 1024, 0, tile);
    cvt_seg(a.in[25] + (size_t)l * 512 * 1024, 1024, 0, (bf16_t*)(wb + WB_WO) + 1024 * 512, 512, 0, 1024, 0, tile);
    cvt_seg(a.in[26] + (size_t)l * 512 * 1024, 1024, 0, (bf16_t*)(wb + WB_WO) + 2 * 1024 * 512, 512, 0, 1024, 0, tile);
    cvt_seg(a.in[27] + (size_t)l * 1024 * 1024, 1024, 0, (bf16_t*)(wb + WB_WOUT), 1024, 0, 1024, 0, tile);
    cvt_seg(a.in[29] + (size_t)l * 1024 * 5632, 5632, 0, (bf16_t*)(wb + WB_WUP), 1024, 0, 5632, 1, tile);
    cvt_seg(a.in[32] + (size_t)l * DFF * 1024, 1024, 0, (bf16_t*)(wb + WB_WDN), DFF, 0, 1024, 0, tile);
}
__device__ __forceinline__ void norm_rows(int mode, const float* x, const float* meta, float* z, const float* w, bf16_t* h, float* out) {
    int tid; asm volatile("v_mov_b32 %0, %1" : "=v"(tid) : "v"((int)threadIdx.x));
    const int lane = tid & 63, wave = tid >> 6;
    f32x4 wv[4];
#pragma unroll
    for (int i = 0; i < 4; ++i) wv[i] = *(const f32x4*)(w + lane * 4 + 256 * i);
    for (int row = blockIdx.x * 8 + wave; row < MROWS; row += gridDim.x * 8) {
        const int b = row / TS, t = row - b * TS;
        const float* src = (mode == 0) ? (t < 16 ? meta + (size_t)t * 1024 : x + ((size_t)b * 2048 + (t - 16)) * 1024) : z + (size_t)row * 1024;
        if (mode == 2 && t < 16) continue;
        f32x4 v[4]; float ss = 0.f;
#pragma unroll
        for (int i = 0; i < 4; ++i) { v[i] = *(const f32x4*)(src + lane * 4 + 256 * i); ss += v[i][0] * v[i][0] + v[i][1] * v[i][1] + v[i][2] * v[i][2] + v[i][3] * v[i][3]; }
        ss = wave_sum(ss);
        const float rstd = rsqrtf(ss * (1.0f / 1024.0f) + 1e-6f);
#pragma unroll
        for (int i = 0; i < 4; ++i) {
            if (mode == 0) *(f32x4*)(z + (size_t)row * 1024 + lane * 4 + 256 * i) = v[i];
            const f32x4 y = v[i] * rstd * wv[i];
            if (mode == 2) *(f32x4*)(out + ((size_t)b * 2048 + (t - 16)) * 1024 + lane * 4 + 256 * i) = y;
            else { u32x2 p; p.x = pk2(y[0], y[1]); p.y = pk2(y[2], y[3]); *(u32x2*)(h + (size_t)row * 1024 + lane * 4 + 256 * i) = p; }
        }
    }
}

__device__ __forceinline__ f32x4 mfma16(bf16x8 a, bf16x8 b, f32x4 c) { return __builtin_amdgcn_mfma_f32_16x16x32_bf16(a, b, c, 0, 0, 0); }
template <int DK, bool HG>
__device__ __forceinline__ void gla_unit(unsigned char* lds, bf16_t* P, int b, int h, int layer, const Args& a) {
    constexpr int NG = 512 / DK, RPG = 32 / NG, LQ = DK + 8, NA = DK / 16;
    bf16_t* RAWQ = (bf16_t*)lds; bf16_t* RAWK = RAWQ + 32 * DK; bf16_t* RAWV = RAWK + 32 * DK; bf16_t* RAWX = RAWV + 32 * 128;
    bf16_t* QT = RAWX + 32 * 16; bf16_t* KT = QT + 32 * LQ; bf16_t* QH = KT + 32 * LQ; bf16_t* KHT = QH + 32 * LQ; bf16_t* VT = KHT + DK * 40; bf16_t* SC = VT + 128 * 40;
    float* DEC = (float*)(SC + 32 * 40); float* TOT = DEC + DK; float* RED = TOT + NG * DK;
    int tid; asm volatile("v_mov_b32 %0, %1" : "=v"(tid) : "v"((int)threadIdx.x));
    const int lane = tid & 63, w = tid >> 6, l16 = lane & 15, g4 = lane >> 4;
    const int qcol = HG ? PC_HQ + 128 * h : PC_GQ + 64 * h, kcol = HG ? PC_HF + 128 * h : PC_GK + 64 * h, vcol = HG ? PC_HI + 128 * h : PC_GV + 128 * h, gcol = HG ? PC_HG + 128 * h : PC_GG + 128 * h;
    const size_t rowbase = (size_t)b * TS;
    const int d = tid % DK, rg = tid / DK;
    float lb = 0.f, up[16], bias = 0.f;
    if (HG) { if (layer == 1) { const float l0 = a.in[22][h * 128 + d], l1 = a.in[22][512 + h * 128 + d]; lb = sigmoidf_(l1 - l0); } }
    else {
#pragma unroll
        for (int j = 0; j < 16; ++j) up[j] = a.in[7][(size_t)layer * 16 * 256 + j * 256 + 64 * h + d];
        bias = a.in[8][layer * 256 + 64 * h + d];
    }
    const float onemlb = 1.0f - lb;
    const float nw = (HG ? a.in[23] : a.in[9])[layer * 128 + 16 * w + l16];
    f32x4 S[NA];
#pragma unroll
    for (int i = 0; i < NA; ++i) S[i] = (f32x4){0.f, 0.f, 0.f, 0.f};
    constexpr int QP = DK / 8;
    const bool hasq = tid < 32 * QP;
    const int qrow = tid / QP, qcg = tid % QP, vrow = tid >> 4, vcg = tid & 15;
    u32x4 rq, rk, rv, rx;
    auto load_chunk = [&](int n) {
        const u32x4 zz = (u32x4){0u, 0u, 0u, 0u}; rq = zz; rk = zz; rv = zz; rx = zz;
        if (hasq) { const int t = 32 * n + qrow - 16; if (t >= 0) { const bf16_t* rp = P + (rowbase + t) * LDP; rq = *(const u32x4*)(rp + qcol + 8 * qcg); rk = *(const u32x4*)(rp + kcol + 8 * qcg); } }
        { const int t = 32 * n + vrow - 16; if (t >= 0) rv = *(const u32x4*)(P + (rowbase + t) * LDP + vcol + 8 * vcg); }
        if (!HG && tid < 64) { const int t = 32 * n + (tid >> 1) - 16; if (t >= 0) rx = *(const u32x4*)(P + (rowbase + t) * LDP + PC_GGK + 8 * (tid & 1)); }
    };
    load_chunk(0);
    for (int n = 0; n < 65; ++n) {
        if (hasq) { *(u32x4*)(RAWQ + qrow * DK + 8 * qcg) = rq; *(u32x4*)(RAWK + qrow * DK + 8 * qcg) = rk; }
        *(u32x4*)(RAWV + vrow * 128 + 8 * vcg) = rv;
        if (!HG && tid < 64) *(u32x4*)(RAWX + (tid >> 1) * 16 + 8 * (tid & 1)) = rx;
        __syncthreads();
        if (n + 1 < 65) load_chunk(n + 1);
        float cum[RPG], kv[RPG]; float run = 0.f;
#pragma unroll
        for (int r = 0; r < RPG; ++r) {
            const int i = rg * RPG + r; const bool valid = (n > 0) || (i >= 16);
            float gg, kk;
            if (HG) { const float zf = bf2f(RAWK[i * DK + d]); const float sg = sigmoidf_(zf); gg = __logf(fmaxf(lb + onemlb * sg, 1e-30f)); kk = onemlb / (1.0f + __expf(zf)); }
            else { float xx = bias;
#pragma unroll
                for (int j = 0; j < 16; ++j) xx += bf2f(RAWX[i * 16 + j]) * up[j];
                gg = -softplusf_(-xx) * (1.0f / 16.0f); kk = bf2f(RAWK[i * DK + d]); }
            if (!valid) { gg = 0.f; kk = 0.f; }
            run += gg; cum[r] = run; kv[r] = kk;
        }
        TOT[rg * DK + d] = run;
        __syncthreads();
        {
            float off = 0.f, bref = 0.f, blast = 0.f;
#pragma unroll
            for (int q = 0; q < NG; ++q) { const float tq = TOT[q * DK + d]; if (q < rg) off += tq; if (q < NG / 2) bref += tq; blast += tq; }
            unsigned short kh[RPG];
#pragma unroll
            for (int r = 0; r < RPG; ++r) {
                const int i = rg * RPG + r; const float bb = off + cum[r];
                const float qv = bf2f(RAWQ[i * DK + d]) * (HG ? 1.0f : 0.125f);
                QT[i * LQ + d] = (bf16_t)f2bf(qv * __expf(bb - bref));
                KT[i * LQ + d] = (bf16_t)f2bf(kv[r] * __expf(bref - bb));
                QH[i * LQ + d] = (bf16_t)f2bf(qv * __expf(bb));
                kh[r] = (unsigned short)f2bf(kv[r] * __expf(blast - bb));
            }
            if (RPG == 8) { u32x4 wv; wv.x = kh[0] | ((unsigned)kh[1] << 16); wv.y = kh[2] | ((unsigned)kh[3] << 16); wv.z = kh[4 % RPG] | ((unsigned)kh[5 % RPG] << 16); wv.w = kh[6 % RPG] | ((unsigned)kh[7 % RPG] << 16); *(u32x4*)(KHT + d * 40 + rg * 8) = wv; }
            else { u32x2 wv; wv.x = kh[0] | ((unsigned)kh[1] << 16); wv.y = kh[2] | ((unsigned)kh[3] << 16); *(u32x2*)(KHT + d * 40 + rg * 4) = wv; }
            if (rg == 0) DEC[d] = __expf(blast);
            const int dv = tid & 127, rgv = tid >> 7;
            unsigned short vv[8];
#pragma unroll
            for (int r = 0; r < 8; ++r) vv[r] = RAWV[(8 * rgv + r) * 128 + dv];
            u32x4 wv; wv.x = vv[0] | ((unsigned)vv[1] << 16); wv.y = vv[2] | ((unsigned)vv[3] << 16); wv.z = vv[4] | ((unsigned)vv[5] << 16); wv.w = vv[6] | ((unsigned)vv[7] << 16);
            *(u32x4*)(VT + dv * 40 + 8 * rgv) = wv;
        }
        __syncthreads();
        if (w < 4) {
            const int ri = w >> 1, cj = w & 1; f32x4 s = (f32x4){0.f, 0.f, 0.f, 0.f};
            if (!(ri == 0 && cj == 1)) {
#pragma unroll
                for (int ks = 0; ks < DK / 32; ++ks) { const bf16x8 A = *(const bf16x8*)(QT + (16 * ri + l16) * LQ + 32 * ks + 8 * g4); const bf16x8 B = *(const bf16x8*)(KT + (16 * cj + l16) * LQ + 32 * ks + 8 * g4); s = mfma16(A, B, s); }
            }
#pragma unroll
            for (int e = 0; e < 4; ++e) { const int i = 16 * ri + 4 * g4 + e, j = 16 * cj + l16; SC[i * 40 + j] = (bf16_t)f2bf(i >= j ? s[e] : 0.f); }
        }
        f32x4 O[2];
#pragma unroll
        for (int rt = 0; rt < 2; ++rt) {
            O[rt] = (f32x4){0.f, 0.f, 0.f, 0.f};
#pragma unroll
            for (int ks = 0; ks < DK / 32; ++ks) {
                const bf16x4 lo = *(const bf16x4*)(QH + (16 * rt + l16) * LQ + 32 * ks + 4 * g4), hi = *(const bf16x4*)(QH + (16 * rt + l16) * LQ + 32 * ks + 16 + 4 * g4);
                bf16x8 A; A[0] = lo[0]; A[1] = lo[1]; A[2] = lo[2]; A[3] = lo[3]; A[4] = hi[0]; A[5] = hi[1]; A[6] = hi[2]; A[7] = hi[3];
                bf16x8 B;
#pragma unroll
                for (int e = 0; e < 4; ++e) { B[e] = (short)f2bf(S[2 * ks][e]); B[4 + e] = (short)f2bf(S[2 * ks + 1][e]); }
                O[rt] = mfma16(A, B, O[rt]);
            }
        }
        __syncthreads();
        {
            const bf16x8 Bv = *(const bf16x8*)(VT + (16 * w + l16) * 40 + 8 * g4);
#pragma unroll
            for (int rt = 0; rt < 2; ++rt) { const bf16x8 A = *(const bf16x8*)(SC + (16 * rt + l16) * 40 + 8 * g4); O[rt] = mfma16(A, Bv, O[rt]); }
#pragma unroll
            for (int i = 0; i < NA; ++i) { const f32x4 dc = *(const f32x4*)(DEC + 16 * i + 4 * g4); S[i] = S[i] * dc; const bf16x8 A = *(const bf16x8*)(KHT + (16 * i + l16) * 40 + 8 * g4); S[i] = mfma16(A, Bv, S[i]); }
#pragma unroll
            for (int rt = 0; rt < 2; ++rt)
#pragma unroll
                for (int e = 0; e < 4; ++e) { const float sq = red16(O[rt][e] * O[rt][e]); if (l16 == 0) RED[w * 32 + 16 * rt + 4 * g4 + e] = sq; }
        }
        __syncthreads();
#pragma unroll
        for (int rt = 0; rt < 2; ++rt)
#pragma unroll
            for (int e = 0; e < 4; ++e) {
                const int i = 16 * rt + 4 * g4 + e, t = 32 * n + i - 16;
                float tot = 0.f;
#pragma unroll
                for (int q = 0; q < 8; ++q) tot += RED[q * 32 + i];
                const float rstd = rsqrtf(tot * (1.0f / 128.0f) + 1e-6f);
                if (t >= 0) { bf16_t* gp = P + (rowbase + t) * LDP + gcol + 16 * w + l16; const float gt = bf2f(*gp); *gp = (bf16_t)f2bf(O[rt][e] * rstd * nw * gt * sigmoidf_(gt)); }
            }
    }
}

__device__ __forceinline__ bf16x8 load_bfrag(const float* W, int s, int g4, int C) {
    bf16x8 r;
#pragma unroll
    for (int j = 0; j < 8; ++j) r[j] = (short)f2bf(W[(size_t)(32 * s + 8 * g4 + j) * 512 + C]);
    return r;
}
__device__ __forceinline__ void rwkv_unit(unsigned char* lds, bf16_t* P, bf16_t* VF, int b, int h, int layer, const Args& a) {
    bf16_t* SW = (bf16_t*)lds; bf16_t* SA = SW + 32 * 72; bf16_t* SG = SA + 32 * 72; bf16_t* SVR = SG + 32 * 136;
    float* Rr = (float*)(SVR + 32 * 40); float* KP = Rr + 2048; float* KK = KP + 2048; float* BV = KK + 2048; float* DEC = BV + 2048; float* VV = DEC + 2048;
    float* GG = VV + 2048; float* AA = GG + 2048; float* VG = AA + 2048; float* Y = VG + 2048; float* BON = Y + 2048; float* RLAST = BON + 32;
    int tid; asm volatile("v_mov_b32 %0, %1" : "=v"(tid) : "v"((int)threadIdx.x));
    const int lane = tid & 63, w = tid >> 6, l16 = lane & 15, g4 = lane >> 4;
    const size_t rowbase = (size_t)b * TS;
    const int ti = tid >> 4, q = tid & 15, C4 = 64 * h + 4 * q;
    const float* mu = a.in[5] + (size_t)layer * 1792;
    const int rt = w >> 2, ct = w & 3, Cm = 64 * h + 16 * ct + l16;
    bf16x8 Bw[2], Ba[2], Bg[4], Bvr;
#pragma unroll
    for (int s = 0; s < 2; ++s) { Bw[s] = load_bfrag(a.in[11] + (size_t)layer * 64 * 512, s, g4, Cm); Ba[s] = load_bfrag(a.in[13] + (size_t)layer * 64 * 512, s, g4, Cm); }
#pragma unroll
    for (int s = 0; s < 4; ++s) Bg[s] = load_bfrag(a.in[16] + (size_t)layer * 128 * 512, s, g4, Cm);
    Bvr = (bf16x8){0, 0, 0, 0, 0, 0, 0, 0};
    float v0c = 0.f;
    if (layer == 1) { Bvr = load_bfrag(a.in[15], 0, g4, Cm); v0c = a.in[14][Cm]; }
    const float w0c = a.in[10][layer * 512 + Cm], a0c = a.in[12][layer * 512 + Cm];
    const int sv = tid >> 3, kg = tid & 7;
    float St[8];
#pragma unroll
    for (int j = 0; j < 8; ++j) St[j] = 0.f;

    for (int c = 0; c < 65; ++c) {
        const int t0 = 32 * c, t = t0 + ti; const bool valid = t < TS;
        f32x4 r4 = (f32x4){0.f, 0.f, 0.f, 0.f}, k4 = r4, v4 = r4, vf4 = r4;
        {
            const bf16_t* rp = P + (rowbase + t) * LDP; const bf16_t* pp = rp - LDP;
            const bool hasprev = t > 0;
            f32x4 sw = r4, sa = r4, sg0 = r4, sg1 = r4; float sv0 = 0.f, sv1 = 0.f;
            if (valid) {
                const f32x4 mu_r = *(const f32x4*)(mu + C4), mu_k = *(const f32x4*)(mu + 576 + C4), mu_v = *(const f32x4*)(mu + 1088 + C4);
                const f32x4 mu_w = *(const f32x4*)(mu + 512 + 4 * q), mu_a = *(const f32x4*)(mu + 1600 + 4 * q), mu_g0 = *(const f32x4*)(mu + 1664 + 8 * q), mu_g1 = *(const f32x4*)(mu + 1664 + 8 * q + 4);
                float mu_vr0 = 0.f, mu_vr1 = 0.f; if (layer == 1) { mu_vr0 = a.in[6][2 * q]; mu_vr1 = a.in[6][2 * q + 1]; }
                const u32x2 cr = *(const u32x2*)(rp + PC_RR + C4), ck = *(const u32x2*)(rp + PC_RK + C4), cv = *(const u32x2*)(rp + PC_RV + C4);
                const u32x2 cwv = *(const u32x2*)(rp + PC_RW + 4 * q), cav = *(const u32x2*)(rp + PC_RA + 4 * q); const u32x4 cgv = *(const u32x4*)(rp + PC_RG + 8 * q); const unsigned cvr = *(const unsigned*)(rp + PC_RVR + 2 * q);
                u32x2 pr = (u32x2){0u, 0u}, pk = pr, pv = pr, pwv = pr, pav = pr; u32x4 pgv = (u32x4){0u, 0u, 0u, 0u}; unsigned pvr = 0u;
                f32x4 prf = (f32x4){0.f, 0.f, 0.f, 0.f};
                if (hasprev) {
                    pk = *(const u32x2*)(pp + PC_RK + C4); pv = *(const u32x2*)(pp + PC_RV + C4);
                    pwv = *(const u32x2*)(pp + PC_RW + 4 * q); pav = *(const u32x2*)(pp + PC_RA + 4 * q); pgv = *(const u32x4*)(pp + PC_RG + 8 * q); pvr = *(const unsigned*)(pp + PC_RVR + 2 * q);
                    if (ti == 0) prf = *(const f32x4*)(RLAST + ((c + 1) & 1) * 64 + 4 * q);
                    else { pr = *(const u32x2*)(pp + PC_RR + C4); prf = (f32x4){bflo(pr.x), bfhi(pr.x), bflo(pr.y), bfhi(pr.y)}; }
                }
                const f32x4 crf = (f32x4){bflo(cr.x), bfhi(cr.x), bflo(cr.y), bfhi(cr.y)};
                if (ti == 31) *(f32x4*)(RLAST + (c & 1) * 64 + 4 * q) = crf;
                r4 = crf + (prf - crf) * mu_r;
                const f32x4 ckf = (f32x4){bflo(ck.x), bfhi(ck.x), bflo(ck.y), bfhi(ck.y)}, pkf = (f32x4){bflo(pk.x), bfhi(pk.x), bflo(pk.y), bfhi(pk.y)};
                k4 = ckf + (pkf - ckf) * mu_k;
                const f32x4 cvf = (f32x4){bflo(cv.x), bfhi(cv.x), bflo(cv.y), bfhi(cv.y)}, pvf = (f32x4){bflo(pv.x), bfhi(pv.x), bflo(pv.y), bfhi(pv.y)};
                v4 = cvf + (pvf - cvf) * mu_v;
                const f32x4 cwf = (f32x4){bflo(cwv.x), bfhi(cwv.x), bflo(cwv.y), bfhi(cwv.y)}, pwf = (f32x4){bflo(pwv.x), bfhi(pwv.x), bflo(pwv.y), bfhi(pwv.y)};
                sw = cwf + (pwf - cwf) * mu_w;
                const f32x4 caf = (f32x4){bflo(cav.x), bfhi(cav.x), bflo(cav.y), bfhi(cav.y)}, paf = (f32x4){bflo(pav.x), bfhi(pav.x), bflo(pav.y), bfhi(pav.y)};
                sa = caf + (paf - caf) * mu_a;
                const f32x4 cg0 = (f32x4){bflo(cgv.x), bfhi(cgv.x), bflo(cgv.y), bfhi(cgv.y)}, pg0 = (f32x4){bflo(pgv.x), bfhi(pgv.x), bflo(pgv.y), bfhi(pgv.y)};
                const f32x4 cg1 = (f32x4){bflo(cgv.z), bfhi(cgv.z), bflo(cgv.w), bfhi(cgv.w)}, pg1 = (f32x4){bflo(pgv.z), bfhi(pgv.z), bflo(pgv.w), bfhi(pgv.w)};
                sg0 = cg0 + (pg0 - cg0) * mu_g0; sg1 = cg1 + (pg1 - cg1) * mu_g1;
                sv0 = bflo(cvr) + (bflo(pvr) - bflo(cvr)) * mu_vr0; sv1 = bfhi(cvr) + (bfhi(pvr) - bfhi(cvr)) * mu_vr1;
                if (layer == 1) { const u32x2 vfw = *(const u32x2*)(VF + (rowbase + t) * 512 + C4); vf4 = (f32x4){bflo(vfw.x), bfhi(vfw.x), bflo(vfw.y), bfhi(vfw.y)}; }
            }
            u32x2 o; o.x = pk2(tanhf_(sw[0]), tanhf_(sw[1])); o.y = pk2(tanhf_(sw[2]), tanhf_(sw[3])); *(u32x2*)(SW + ti * 72 + 4 * q) = o;
            o.x = pk2(sa[0], sa[1]); o.y = pk2(sa[2], sa[3]); *(u32x2*)(SA + ti * 72 + 4 * q) = o;
            u32x4 og; og.x = pk2(sigmoidf_(sg0[0]), sigmoidf_(sg0[1])); og.y = pk2(sigmoidf_(sg0[2]), sigmoidf_(sg0[3])); og.z = pk2(sigmoidf_(sg1[0]), sigmoidf_(sg1[1])); og.w = pk2(sigmoidf_(sg1[2]), sigmoidf_(sg1[3]));
            *(u32x4*)(SG + ti * 136 + 8 * q) = og;
            *(unsigned*)(SVR + ti * 40 + 2 * q) = (layer == 1) ? pk2(sv0, sv1) : 0u;
            if (q < 4) *(unsigned*)(SVR + ti * 40 + 32 + 2 * q) = 0u;
        }
        __syncthreads();
        {
            f32x4 cw = (f32x4){0.f, 0.f, 0.f, 0.f}, ca = cw, cgt = cw, cvv = cw;
#pragma unroll
            for (int s = 0; s < 2; ++s) { cw = mfma16(*(const bf16x8*)(SW + (16 * rt + l16) * 72 + 32 * s + 8 * g4), Bw[s], cw); ca = mfma16(*(const bf16x8*)(SA + (16 * rt + l16) * 72 + 32 * s + 8 * g4), Ba[s], ca); }
#pragma unroll
            for (int s = 0; s < 4; ++s) cgt = mfma16(*(const bf16x8*)(SG + (16 * rt + l16) * 136 + 32 * s + 8 * g4), Bg[s], cgt);
            if (layer == 1) cvv = mfma16(*(const bf16x8*)(SVR + (16 * rt + l16) * 40 + 8 * g4), Bvr, cvv);
#pragma unroll
            for (int e = 0; e < 4; ++e) {
                const int idx = (16 * rt + 4 * g4 + e) * 64 + 16 * ct + l16;
                const float wl = -softplusf_(-(w0c + cw[e])) - 0.5f;
                DEC[idx] = __expf(-__expf(wl)); AA[idx] = sigmoidf_(a0c + ca[e]); GG[idx] = cgt[e]; VG[idx] = sigmoidf_(v0c + cvv[e]);
            }
        }
        __syncthreads();
        {
            const f32x4 a4 = *(const f32x4*)(AA + ti * 64 + 4 * q);
            if (layer == 1) { const f32x4 vg = *(const f32x4*)(VG + ti * 64 + 4 * q); v4 = v4 + (vf4 - v4) * vg; }
            else if (valid) { u32x2 o; o.x = pk2(v4[0], v4[1]); o.y = pk2(v4[2], v4[3]); *(u32x2*)(VF + (rowbase + t) * 512 + C4) = o; }
            const f32x4 kkw = *(const f32x4*)(a.in[17] + layer * 512 + C4), kaw = *(const f32x4*)(a.in[18] + layer * 512 + C4), rkw = *(const f32x4*)(a.in[19] + layer * 512 + C4);
            f32x4 kk = k4 * kkw;
            const float ss = red16(kk[0] * kk[0] + kk[1] * kk[1] + kk[2] * kk[2] + kk[3] * kk[3]);
            kk = kk * (1.0f / fmaxf(sqrtf(ss), 1e-12f));
            const f32x4 kp = k4 * (1.0f + (a4 - 1.0f) * kaw);
            const f32x4 rkp = r4 * kp * rkw;
            const float bon = red16(rkp[0] + rkp[1] + rkp[2] + rkp[3]);
            *(f32x4*)(Rr + ti * 64 + 4 * q) = r4; *(f32x4*)(KP + ti * 64 + 4 * q) = kp; *(f32x4*)(KK + ti * 64 + 4 * q) = kk; *(f32x4*)(BV + ti * 64 + 4 * q) = kk * a4; *(f32x4*)(VV + ti * 64 + 4 * q) = v4;
            if (q == 0) BON[ti] = bon;
        }
        __syncthreads();
        {
            const int nv = (TS - t0) < 32 ? (TS - t0) : 32;
            for (int i = 0; i < nv; ++i) {
                const f32x4 kk0 = *(const f32x4*)(KK + i * 64 + 8 * kg), kk1 = *(const f32x4*)(KK + i * 64 + 8 * kg + 4);
                const f32x4 dc0 = *(const f32x4*)(DEC + i * 64 + 8 * kg), dc1 = *(const f32x4*)(DEC + i * 64 + 8 * kg + 4);
                const f32x4 bv0 = *(const f32x4*)(BV + i * 64 + 8 * kg), bv1 = *(const f32x4*)(BV + i * 64 + 8 * kg + 4);
                const f32x4 kp0 = *(const f32x4*)(KP + i * 64 + 8 * kg), kp1 = *(const f32x4*)(KP + i * 64 + 8 * kg + 4);
                const f32x4 rr0 = *(const f32x4*)(Rr + i * 64 + 8 * kg), rr1 = *(const f32x4*)(Rr + i * 64 + 8 * kg + 4);
                const float vv = VV[i * 64 + sv];
                float sa = (St[0] * kk0[0] + St[1] * kk0[1]) + (St[2] * kk0[2] + St[3] * kk0[3]) + (St[4] * kk1[0] + St[5] * kk1[1]) + (St[6] * kk1[2] + St[7] * kk1[3]);
                sa = -red8(sa);
#pragma unroll
                for (int j = 0; j < 4; ++j) { St[j] = St[j] * dc0[j] + sa * bv0[j] + vv * kp0[j]; St[4 + j] = St[4 + j] * dc1[j] + sa * bv1[j] + vv * kp1[j]; }
                float y = (St[0] * rr0[0] + St[1] * rr0[1]) + (St[2] * rr0[2] + St[3] * rr0[3]) + (St[4] * rr1[0] + St[5] * rr1[1]) + (St[6] * rr1[2] + St[7] * rr1[3]);
                y = red8(y);
                if (kg == 0) Y[i * 64 + sv] = y;
            }
        }
        __syncthreads();
        {
            const f32x4 y4 = *(const f32x4*)(Y + ti * 64 + 4 * q), gg = *(const f32x4*)(GG + ti * 64 + 4 * q);
            const float mean = red16(y4[0] + y4[1] + y4[2] + y4[3]) * (1.0f / 64.0f);
            const f32x4 dd = y4 - mean;
            const float var = red16(dd[0] * dd[0] + dd[1] * dd[1] + dd[2] * dd[2] + dd[3] * dd[3]) * (1.0f / 64.0f);
            const f32x4 lnw = *(const f32x4*)(a.in[20] + layer * 512 + C4), lnb = *(const f32x4*)(a.in[21] + layer * 512 + C4);
            const f32x4 yn = dd * rsqrtf(var + 64e-5f) * lnw + lnb;
            const f32x4 o4 = (yn + v4 * BON[ti]) * gg;
            if (valid) { u32x2 o; o.x = pk2(o4[0], o4[1]); o.y = pk2(o4[2], o4[3]); *(u32x2*)(P + (rowbase + t) * LDP + PC_RR + C4) = o; }
        }
    }
}

__global__ void __launch_bounds__(NTHR) mega(Args args) {
    extern __shared__ __attribute__((aligned(16))) unsigned char lds[];
    cg::grid_group grid = cg::this_grid();
    LAS unsigned char* ldsl = (LAS unsigned char*)lds;
    unsigned char* ws = args.ws;
    float* Z = (float*)(ws + WS_Z); bf16_t* P = (bf16_t*)(ws + WS_P); unsigned char* wb = ws + WS_WB;
    bf16_t* H = (bf16_t*)((unsigned char*)args.out + DO_H); bf16_t* VF = (bf16_t*)((unsigned char*)args.out + DO_VF);
    const int G = gridDim.x, c = blockIdx.x;

    convert_weights(args, 0, wb, (float*)lds);
    norm_rows(0, args.in[0], args.in[1], Z, args.in[2], H, nullptr);
    grid.sync();
#pragma unroll 1
    for (int l = 0; l < 2; ++l) {
        if (l == 1) { convert_weights(args, 1, wb, (float*)lds); norm_rows(1, nullptr, nullptr, Z, args.in[2] + 1024, H, nullptr); grid.sync(); }
        {
            pg::GemmPlain g{H, (const bf16_t*)(wb + WB_WIN), 1024, 1024, 1024}; pg::Order2D S; S.init(129, 22, G, c); pg::EpiP E{P};
#ifndef NO_G1
            pg::gemm_phase(ldsl, g, S, E);
#endif
        }
        grid.sync();
        for (int it = c; it < 256; it += G) {
#ifndef NO_RW
            if (it < 128) rwkv_unit(lds, P, VF, it >> 3, it & 7, l, args);
#endif
#ifndef NO_GLA
            if (it >= 128 && it < 192) gla_unit<64, false>(lds, P, (it - 128) >> 2, (it - 128) & 3, l, args);
#endif
#ifndef NO_HG
            if (it >= 192) gla_unit<128, true>(lds, P, (it - 192) >> 2, (it - 192) & 3, l, args);
#endif
            __syncthreads();
        }
        grid.sync();
        {
            pg::GemmPlain g{H, (const bf16_t*)(wb + WB_WG), 1024, 1024, 1024}; pg::Order2D S; S.init(129, 12, G, c); pg::EpiGate E{P};
#ifndef NO_M1
            pg::gemm_phase(ldsl, g, S, E);
#endif
        }
        grid.sync();
        {
            pg::GemmMerge g{P, (const bf16_t*)(wb + WB_WO), LDP, 512, 512}; pg::Order2D S; S.init(129, 4, G, c, 3); pg::EpiMerge E{P, H};
#ifndef NO_M2
            pg::gemm_phase(ldsl, g, S, E);
#endif
        }
        grid.sync();
        {
            pg::GemmPlain g{H, (const bf16_t*)(wb + WB_WOUT), 1024, 1024, 1024}; pg::Order2D S; S.init(129, 4, G, c); pg::EpiResid E{Z};
#ifndef NO_O
            pg::gemm_phase(ldsl, g, S, E);
#endif
        }
        grid.sync();
        norm_rows(1, nullptr, nullptr, Z, args.in[28] + l * 1024, H, nullptr);
        grid.sync();
        {
            pg::GemmUp g{H, (const bf16_t*)(wb + WB_WUP), 1024, 1024, 1024}; pg::Order2D S; S.init(131, 22, G, c);
            pg::EpiFFN E{P, args.in[30] + (size_t)l * 3 * 5632, args.in[31] + (size_t)l * 5632};
#ifndef NO_U
            pg::gemm_phase(ldsl, g, S, E);
#endif
        }
        grid.sync();
        {
            pg::GemmPlain g{P, (const bf16_t*)(wb + WB_WDN), DFF, DFF, DFF}; pg::Order2D S; S.init(129, 4, G, c); pg::EpiResid E{Z};
#ifndef NO_D
            pg::gemm_phase(ldsl, g, S, E);
#endif
        }
        grid.sync();
    }
    norm_rows(2, nullptr, nullptr, Z, args.in[33], nullptr, args.out);
}

extern "C" void kernel_launch(void* const* d_in, const int* in_sizes, int n_in, void* d_out, int out_size, void* d_ws, size_t ws_size, hipStream_t stream) {
    static int grid = 0;
    if (grid == 0) {
        int dev = 0, cus = 0, per_cu = 0;
        hipGetDevice(&dev);
        hipDeviceGetAttribute(&cus, hipDeviceAttributeMultiprocessorCount, dev);
        if (hipFuncSetAttribute((const void*)mega, hipFuncAttributeMaxDynamicSharedMemorySize, LDS_BYTES) != hipSuccess) fprintf(stderr, "kernel_launch: hipFuncSetAttribute failed\n");
        if (hipOccupancyMaxActiveBlocksPerMultiprocessor(&per_cu, (const void*)mega, NTHR, LDS_BYTES) != hipSuccess || per_cu < 1) { fprintf(stderr, "kernel_launch: occupancy query gave %d\n", per_cu); per_cu = 1; }
        (void)hipGetLastError();
        grid = cus * per_cu;
        if (n_in != 34 || ws_size < WS_WB + WB_END) fprintf(stderr, "kernel_launch: unexpected n_in %d / ws_size %zu\n", n_in, ws_size);
    }
    Args a{};
    for (int i = 0; i < 34; ++i) a.in[i] = (const float*)d_in[i];
    a.out = (float*)d_out; a.ws = (unsigned char*)d_ws;
    void* kargs[] = {&a};
    hipError_t e = hipLaunchCooperativeKernel((const void*)mega, dim3(grid), dim3(NTHR), kargs, LDS_BYTES, stream);
    if (e != hipSuccess) fprintf(stderr, "kernel_launch: cooperative launch failed: %s (grid %d)\n", hipGetErrorString(e), grid);
}
```

```cpp
#include <hip/hip_runtime.h>
#include <hip/hip_cooperative_groups.h>
#include <cstdio>
#include <cstdint>
namespace cg = cooperative_groups;

#define LAS __attribute__((address_space(3)))
typedef unsigned short bf16_t;
typedef short bf16x8 __attribute__((ext_vector_type(8)));
typedef short bf16x4 __attribute__((ext_vector_type(4)));
typedef float f32x4 __attribute__((ext_vector_type(4)));
typedef unsigned u32x4 __attribute__((ext_vector_type(4)));
typedef unsigned u32x2 __attribute__((ext_vector_type(2)));

constexpr int NB = 16, TS = 2064, MROWS = NB * TS  , DM = 1024, LDP = 5424, DFF = 2816;
constexpr int NTHR = 512;
constexpr int PC_GQ = 0, PC_GK = 256, PC_GV = 512, PC_GG = 1024, PC_HQ = 1536, PC_HF = 2048, PC_HI = 2560, PC_HG = 3072,
              PC_RR = 3584, PC_RK = 4096, PC_RV = 4608, PC_RW = 5120, PC_RA = 5184, PC_RG = 5248, PC_RVR = 5376, PC_GGK = 5408;
constexpr size_t WS_Z = 65536;
constexpr size_t WS_P = WS_Z + (size_t)MROWS * DM * 4;
constexpr size_t WS_WB = WS_P + (size_t)MROWS * LDP * 2;
constexpr size_t WB_WIN = 0, WB_WG = 11534336, WB_WO = 17825792, WB_WOUT = 20971520, WB_WUP = 23068672, WB_WDN = 34603008, WB_END = 40370176;
static_assert(WS_WB + WB_END <= 536870912ull, "ws map");
constexpr size_t DO_H = 4096, DO_VF = 68157440;
constexpr int LDS_BYTES = 147456;
constexpr int LDS_XCH = 131072;

struct Args { const float* in[34]; float* out; unsigned char* ws; };

typedef __bf16 bf16x2_t __attribute__((ext_vector_type(2)));
typedef float f32x2_t __attribute__((ext_vector_type(2)));
__device__ __forceinline__ unsigned pk2(float lo, float hi) { const f32x2_t v = {lo, hi}; const bf16x2_t b = __builtin_convertvector(v, bf16x2_t); return __builtin_bit_cast(unsigned, b); }
__device__ __forceinline__ unsigned f2bf(float f) { return pk2(f, f) & 0xffffu; }
__device__ __forceinline__ bf16x8 pk8(f32x4 a, f32x4 b) { u32x4 w; w.x = pk2(a[0], a[1]); w.y = pk2(a[2], a[3]); w.z = pk2(b[0], b[1]); w.w = pk2(b[2], b[3]); return __builtin_bit_cast(bf16x8, w); }
__device__ __forceinline__ float bf2f(unsigned short h) { return __builtin_bit_cast(float, (unsigned)h << 16); }
__device__ __forceinline__ float bflo(unsigned w) { return __builtin_bit_cast(float, w << 16); }
__device__ __forceinline__ float bfhi(unsigned w) { return __builtin_bit_cast(float, w & 0xffff0000u); }
__device__ __forceinline__ float sigmoidf_(float x) { return __builtin_amdgcn_rcpf(1.0f + __expf(-x)); }
__device__ __forceinline__ float logfast_(float x) { return __builtin_amdgcn_logf(x) * 0.69314718056f; }
__device__ __forceinline__ float softplusf_(float x) { return fmaxf(x, 0.f) + logfast_(1.0f + __expf(-fabsf(x))); }
__device__ __forceinline__ float tanhf_(float x) { float e = __expf(2.0f * x); return 1.0f - 2.0f * __builtin_amdgcn_rcpf(e + 1.0f); }
template <int CTRL> __device__ __forceinline__ float dppf(float x) {
    return __builtin_bit_cast(float, __builtin_amdgcn_update_dpp(0, __builtin_bit_cast(int, x), CTRL, 0xf, 0xf, true));
}
__device__ __forceinline__ float red8(float x) { x += dppf<0xB1>(x); x += dppf<0x4E>(x); x += dppf<0x141>(x); return x; }
__device__ __forceinline__ float red16(float x) { x = red8(x); x += dppf<0x140>(x); return x; }
__device__ __forceinline__ float wave_sum(float v) {
#pragma unroll
    for (int o = 32; o > 0; o >>= 1) v += __shfl_xor(v, o, 64);
    return v;
}
#define LDS_WAIT() asm volatile("s_waitcnt lgkmcnt(0)" ::: "memory")
#define WG_BAR() do { asm volatile("s_waitcnt lgkmcnt(0)" ::: "memory"); __builtin_amdgcn_s_barrier(); asm volatile("" ::: "memory"); } while (0)

namespace pg {
constexpr int BM = 256, BK = 64, HALF = 128, HTB = HALF * BK * 2, STAGE_BYTES = 8 * HTB, NXCD = 8, WGM = 8;
__host__ __device__ __forceinline__ int lds_byte(int r, int c) { const int st = (r >> 4) * 2 + (c >> 5), rr = r & 15, cc = c & 31, ob = rr * 64 + cc * 2; return st * 1024 + (ob ^ (((ob >> 9) & 1) << 5)); }
__host__ __device__ __forceinline__ void stage_rc(int b, int& R, int& C) { const int st = b / 1024, sb = b % 1024, swz = sb ^ (((sb >> 9) & 1) << 5); R = (st >> 1) * 16 + swz / 64; C = (st & 1) * 32 + (swz % 64) / 2; }
__host__ __device__ __forceinline__ int perm32(int rho) { const int n = rho >> 4, i = rho & 15; return 8 * (i >> 2) + 4 * n + (i & 3); }

struct Unit { int pm, pn, aux, half; };

struct Order2D {
    int nM, nN, nwg, G, c, rep, mode;
    __device__ void init(int nM_, int nN_, int G_, int c_, int rep_ = 1, int mode_ = 0) { nM = nM_; nN = nN_; nwg = nM * nN; G = G_; c = c_; rep = rep_; mode = mode_; }
    __device__ bool next(int i, Unit& u) const {
        const int ti = i / rep; u.aux = i - ti * rep; u.half = -1;
        long L = (long)ti * G + c;
        if (mode == 1) { if (ti >= nwg / G) return false; }
        if (mode == 2) { const int full = nwg / G, rem = nwg - full * G; if (ti > 0 || c >= 2 * rem) return false; L = (long)full * G + (c >> 1); u.half = c & 1; }
        if (L >= nwg) return false;
        int wgid = (int)L; { const int q = nwg / NXCD, r = nwg % NXCD, xcd = wgid % NXCD, off = wgid / NXCD; wgid = (xcd < r ? xcd * (q + 1) : r * (q + 1) + (xcd - r) * q) + off; }
        const int nig = WGM * nN, gid = wgid / nig, fm = gid * WGM, gsz = (nM - fm) < WGM ? (nM - fm) : WGM;
        u.pm = fm + ((wgid % nig) % gsz); u.pn = (wgid % nig) / gsz; return true;
    }
};

struct OrderSplit {
    Order2D base; int full, S;
    __device__ void init(int nM_, int nN_, int G_, int c_, int S_) { base.init(nM_, nN_, G_, c_); full = base.nwg / G_; S = S_; }
    __device__ bool next(int i, Unit& u) const {
        if (i < full) { const bool ok = base.next(i, u); u.aux = -1; return ok; }
        if (i > full) return false;
        const int rem = base.nwg - full * base.G, j = base.c; if (j >= rem * S) return false;
        Order2D t = base; t.c = j / S;
        const bool ok = t.next(full, u); u.aux = j - (j / S) * S; return ok;
    }
};
template <bool HN = false, class Epi, class G, class Sched>
__device__ __forceinline__ void gemm_phase(LAS unsigned char* lds, const G g, const Sched& S, const Epi& E) {
    int tid; asm volatile("v_mov_b32 %0, %1" : "=v"(tid) : "v"((int)threadIdx.x));
    const int wid = __builtin_amdgcn_readfirstlane(tid >> 6), lane = tid & 63, wr = wid >> 2, wc = wid & 3, fr = lane & 15, fq = lane >> 4;
    unsigned voffA[2], voffB[2];
#pragma unroll
    for (int i = 0; i < 2; ++i) { int R, C; stage_rc(tid * 16 + i * 8192, R, C); const int Rb = Epi::PERM ? ((R & ~31) + perm32(R & 31)) : R;
        voffA[i] = (unsigned)(R * g.lda + C) * 2u; voffB[i] = (unsigned)(Rb * g.ldb + C) * 2u; }
    const size_t kstep = (size_t)(BK * 2);
    const size_t hstepA = (size_t)HALF * g.lda * 2, hstepB = (size_t)HALF * g.ldb * 2;
    const unsigned ldsw = (unsigned)wid * 1024u;
    const int aoff = lds_byte(wr * 64 + fr, fq * 8), boff = lds_byte(wc * 32 + fr, fq * 8);
#define PG_SA(b, h) (((b) * 2 + (h)) * HTB)
#define PG_SB(b, h) ((4 + (b) * 2 + (h)) * HTB)
#define PG_STAGE(bufoff, gbase, voff) do { _Pragma("unroll") for (int _i = 0; _i < 2; ++_i) \
        __builtin_amdgcn_global_load_lds((const unsigned*)((const char*)(gbase) + (voff)[_i]), (LAS unsigned*)(lds + (bufoff) + ldsw + _i * 8192), 16, 0, 0); } while (0)
#define PG_LDA(dst, b, h) do { _Pragma("unroll") for (int m = 0; m < 4; ++m) _Pragma("unroll") for (int k = 0; k < 2; ++k) dst[m][k] = *(const LAS bf16x8*)(lds + PG_SA(b, h) + aoff + m * 2048 + k * 1024); } while (0)
#define PG_LDB(dst, b, h) do { _Pragma("unroll") for (int n = 0; n < 2; ++n) _Pragma("unroll") for (int k = 0; k < 2; ++k) dst[n][k] = *(const LAS bf16x8*)(lds + PG_SB(b, h) + boff + n * 2048 + k * 1024); } while (0)
#define PG_MMA(ai, bj, At, Bt) do { __builtin_amdgcn_s_setprio(1); _Pragma("unroll") for (int m = 0; m < 4; ++m) _Pragma("unroll") for (int n = 0; n < 2; ++n) _Pragma("unroll") for (int k = 0; k < 2; ++k) \
        acc[ai][bj][m][n] = __builtin_amdgcn_mfma_f32_16x16x32_bf16(Bt[n][k], At[m][k], acc[ai][bj][m][n], 0, 0, 0); __builtin_amdgcn_s_setprio(0); } while (0)
#define PG_WAIT_V(n) asm volatile("s_waitcnt vmcnt(" #n ")" ::: "memory")
#define PG_WAIT_L(n) asm volatile("s_waitcnt lgkmcnt(" #n ")" ::: "memory")
#define PG_BAR __builtin_amdgcn_s_barrier()
#define PG_SCHED __builtin_amdgcn_sched_barrier(0)
    Unit cur, nxt; int ui = 0;
    if (!S.next(0, cur)) return;
    f32x4 acc[2][2][4][2];
#pragma unroll
    for (int a = 0; a < 2; ++a)
#pragma unroll
        for (int b = 0; b < 2; ++b)
#pragma unroll
            for (int m = 0; m < 4; ++m)
#pragma unroll
                for (int n = 0; n < 2; ++n) acc[a][b][m][n] = (f32x4){0.f, 0.f, 0.f, 0.f};
    bf16x8 At[4][2], B0[2][2], B1[2][2];
    const char* cA = g.a(cur); const char* cB = g.b(cur);
    PG_STAGE(PG_SB(0, 0), cB, voffB); PG_STAGE(PG_SB(0, 1), cB + hstepB, voffB); PG_STAGE(PG_SA(0, 0), cA, voffA); PG_STAGE(PG_SA(0, 1), cA + hstepA, voffA);
    if (wr == 1) PG_BAR;
    PG_WAIT_V(2); PG_BAR;
    PG_STAGE(PG_SB(1, 0), cB + kstep, voffB); PG_STAGE(PG_SA(1, 0), cA + kstep, voffA); PG_STAGE(PG_SB(1, 1), cB + hstepB + kstep, voffB);
    PG_WAIT_V(6); PG_BAR;
    for (;;) {
        const bool has_next = S.next(ui + 1, nxt);
        const char* nA = has_next ? g.a(nxt) : cA; const char* nB = has_next ? g.b(nxt) : cB;
        const int nt = g.nt(cur);
        for (int t = 0; t < nt; t += 2) {
            const bool last = (t == nt - 2);
            const char* a1 = cA + (size_t)(t + 1) * kstep;
            const char* a2 = last ? nA : cA + (size_t)(t + 2) * kstep; const char* b2 = last ? nB : cB + (size_t)(t + 2) * kstep;
            const char* a3 = a2 + kstep; const char* b3 = b2 + kstep;
            PG_LDB(B0, 0, 0); PG_LDB(B1, 0, 1); PG_SCHED; PG_LDA(At, 0, 0); PG_STAGE(PG_SA(1, 1), a1 + hstepA, voffA);
            PG_WAIT_V(8); PG_WAIT_L(0); PG_BAR; PG_MMA(0, 0, At, B0); if constexpr (!HN) PG_MMA(0, 1, At, B1); PG_BAR; PG_SCHED;
            PG_LDA(At, 0, 1); PG_STAGE(PG_SB(0, 0), b2, voffB); PG_STAGE(PG_SB(0, 1), b2 + hstepB, voffB); PG_STAGE(PG_SA(0, 0), a2, voffA);
            PG_WAIT_V(8); PG_WAIT_L(0); PG_BAR; PG_MMA(1, 0, At, B0); if constexpr (!HN) PG_MMA(1, 1, At, B1); PG_BAR; PG_SCHED;
            PG_LDB(B0, 1, 0); PG_LDB(B1, 1, 1); PG_SCHED; PG_LDA(At, 1, 0); PG_STAGE(PG_SA(0, 1), a2 + hstepA, voffA);
            PG_WAIT_V(8); PG_WAIT_L(0); PG_BAR; PG_MMA(0, 0, At, B0); if constexpr (!HN) PG_MMA(0, 1, At, B1); PG_BAR; PG_SCHED;
            PG_LDA(At, 1, 1); PG_STAGE(PG_SB(1, 0), b3, voffB); PG_STAGE(PG_SB(1, 1), b3 + hstepB, voffB); PG_STAGE(PG_SA(1, 0), a3, voffA);
            PG_WAIT_V(8); PG_WAIT_L(0); PG_BAR; PG_MMA(1, 0, At, B0); if constexpr (!HN) PG_MMA(1, 1, At, B1); PG_BAR; PG_SCHED;
        }
        if (wr == 0) PG_BAR;
        { int te; asm volatile("v_mov_b32 %0, %1" : "=v"(te) : "v"((int)threadIdx.x)); const int le = te & 63; E(acc, cur, wr, wc, le & 15, le >> 4, lds); }
        if (!has_next) break;
#pragma unroll
        for (int a = 0; a < 2; ++a)
#pragma unroll
            for (int b = 0; b < 2; ++b)
#pragma unroll
                for (int m = 0; m < 4; ++m)
#pragma unroll
                    for (int n = 0; n < 2; ++n) acc[a][b][m][n] = (f32x4){0.f, 0.f, 0.f, 0.f};
        cur = nxt; cA = nA; cB = nB; ++ui;
        if (wr == 1) PG_BAR;
    }
    PG_WAIT_V(0);
    PG_BAR;
#undef PG_SA
#undef PG_SB
#undef PG_STAGE
#undef PG_LDA
#undef PG_LDB
#undef PG_MMA
#undef PG_WAIT_V
#undef PG_WAIT_L
#undef PG_BAR
#undef PG_SCHED
}

struct GemmPlain { const bf16_t* A; const bf16_t* Bt; int lda, ldb, K;
    __device__ __forceinline__ const char* a(const Unit& u) const { return (const char*)(A + (size_t)u.pm * 256 * lda); }
    __device__ __forceinline__ const char* b(const Unit& u) const { return (const char*)(Bt + ((size_t)u.pn * 256 + (u.half > 0 ? 128 : 0)) * ldb); }
    __device__ __forceinline__ int nt(const Unit&) const { return K / BK; } };
struct GemmSplit { const bf16_t* A; const bf16_t* Bt; int lda, ldb, K, KS;
    __device__ __forceinline__ const char* a(const Unit& u) const { return (const char*)(A + (size_t)u.pm * 256 * lda + (u.aux > 0 ? u.aux * KS : 0)); }
    __device__ __forceinline__ const char* b(const Unit& u) const { return (const char*)(Bt + (size_t)u.pn * 256 * ldb + (u.aux > 0 ? u.aux * KS : 0)); }
    __device__ __forceinline__ int nt(const Unit& u) const { return (u.aux >= 0 ? KS : K) / BK; } };
struct GemmMerge { const bf16_t* P; const bf16_t* Wo; int lda, ldb, K;
    __device__ __forceinline__ const char* a(const Unit& u) const { const int yc = u.aux == 0 ? PC_GG : (u.aux == 1 ? PC_RR : PC_HG); return (const char*)(P + (size_t)u.pm * 256 * LDP + yc); }
    __device__ __forceinline__ const char* b(const Unit& u) const { return (const char*)(Wo + (size_t)u.aux * 1024 * 512 + ((size_t)u.pn * 256 + (u.half > 0 ? 128 : 0)) * 512); }
    __device__ __forceinline__ int nt(const Unit&) const { return K / BK; } };
struct GemmUp { const bf16_t* H; const bf16_t* Bt; int lda, ldb, K;
    __device__ __forceinline__ const char* a(const Unit& u) const { return (const char*)(H + ((long)u.pm * 254 - 2) * 1024); }
    __device__ __forceinline__ const char* b(const Unit& u) const { return (const char*)(Bt + (size_t)u.pn * 256 * 1024); }
    __device__ __forceinline__ int nt(const Unit&) const { return K / BK; } };

__device__ __forceinline__ int gmap(int j) { return j < 4 ? 256 * j : (j < 10 ? 1536 + 256 * (j - 4) : 4096 + 256 * (j - 10)); }

struct EpiP {
    static constexpr bool PERM = true; bf16_t* P;
    __device__ __forceinline__ void operator()(const f32x4 (&acc)[2][2][4][2], const Unit& u, int wr, int wc, int fr, int fq, LAS unsigned char*) const {
        const int row0 = u.pm * 256 + wr * 64 + fr, col0 = u.pn * 256 + wc * 32 + 8 * fq + (u.half > 0 ? 128 : 0); const int nbj = u.half >= 0 ? 1 : 2;
#pragma unroll
        for (int ai = 0; ai < 2; ++ai)
#pragma unroll
            for (int m = 0; m < 4; ++m) { bf16_t* rowp = P + (size_t)(row0 + ai * 128 + m * 16) * LDP;
#pragma unroll
                for (int bj = 0; bj < 2; ++bj) { const int col = col0 + bj * 128; if (bj < nbj && col < LDP) { const f32x4 v0 = acc[ai][bj][m][0], v1 = acc[ai][bj][m][1];
                    u32x4 w; w.x = pk2(v0[0], v0[1]); w.y = pk2(v0[2], v0[3]); w.z = pk2(v1[0], v1[1]); w.w = pk2(v1[2], v1[3]); *(u32x4*)(rowp + col) = w; } } }
    }
};
struct EpiGate {
    static constexpr bool PERM = true; bf16_t* P;
    __device__ __forceinline__ void operator()(const f32x4 (&acc)[2][2][4][2], const Unit& u, int wr, int wc, int fr, int fq, LAS unsigned char*) const {
        const int row0 = u.pm * 256 + wr * 64 + fr, col0 = gmap(u.pn) + wc * 32 + 8 * fq + (u.half > 0 ? 128 : 0); const int nbj = u.half >= 0 ? 1 : 2;
#pragma unroll
        for (int ai = 0; ai < 2; ++ai)
#pragma unroll
            for (int m = 0; m < 4; ++m) { bf16_t* rowp = P + (size_t)(row0 + ai * 128 + m * 16) * LDP + col0;
#pragma unroll
                for (int bj = 0; bj < 2; ++bj) { if (bj >= nbj) continue; const f32x4 v0 = acc[ai][bj][m][0], v1 = acc[ai][bj][m][1];
                    u32x4 w; w.x = pk2(sigmoidf_(v0[0]), sigmoidf_(v0[1])); w.y = pk2(sigmoidf_(v0[2]), sigmoidf_(v0[3]));
                    w.z = pk2(sigmoidf_(v1[0]), sigmoidf_(v1[1])); w.w = pk2(sigmoidf_(v1[2]), sigmoidf_(v1[3])); *(u32x4*)(rowp + bj * 128) = w; } }
    }
};
struct EpiMerge {
    static constexpr bool PERM = true; const bf16_t* __restrict__ P; bf16_t* __restrict__ Mg;
    __device__ __forceinline__ void operator()(const f32x4 (&acc)[2][2][4][2], const Unit& u, int wr, int wc, int fr, int fq, LAS unsigned char*) const {
        const int row0 = u.pm * 256 + wr * 64 + fr, cin = wc * 32 + 8 * fq + (u.half > 0 ? 128 : 0), br = u.aux; const int nbj = u.half >= 0 ? 1 : 2;
        const int gcol = gmap(4 * br + u.pn) + cin, mcol = u.pn * 256 + cin;
#pragma unroll
        for (int ai = 0; ai < 2; ++ai) {
            u32x4 gw[4][2], pw[4][2];
#pragma unroll
            for (int m = 0; m < 4; ++m)
#pragma unroll
                for (int bj = 0; bj < 2; ++bj) { const size_t row = (size_t)(row0 + ai * 128 + m * 16);
                    gw[m][bj] = (u32x4){0u, 0u, 0u, 0u}; pw[m][bj] = (u32x4){0u, 0u, 0u, 0u};
                    if (bj < nbj) { gw[m][bj] = *(const u32x4*)(P + row * LDP + gcol + bj * 128); if (br > 0) pw[m][bj] = *(const u32x4*)(Mg + row * 1024 + mcol + bj * 128); } }
#pragma unroll
            for (int m = 0; m < 4; ++m)
#pragma unroll
                for (int bj = 0; bj < 2; ++bj) { if (bj >= nbj) continue; const size_t row = (size_t)(row0 + ai * 128 + m * 16);
                    const f32x4 v0 = acc[ai][bj][m][0], v1 = acc[ai][bj][m][1]; const u32x4 g = gw[m][bj], p = pw[m][bj];
                    float r[8] = { bflo(g.x) * v0[0], bfhi(g.x) * v0[1], bflo(g.y) * v0[2], bfhi(g.y) * v0[3], bflo(g.z) * v1[0], bfhi(g.z) * v1[1], bflo(g.w) * v1[2], bfhi(g.w) * v1[3] };
                    r[0] += bflo(p.x); r[1] += bfhi(p.x); r[2] += bflo(p.y); r[3] += bfhi(p.y); r[4] += bflo(p.z); r[5] += bfhi(p.z); r[6] += bflo(p.w); r[7] += bfhi(p.w);
                    u32x4 w; w.x = pk2(r[0], r[1]); w.y = pk2(r[2], r[3]); w.z = pk2(r[4], r[5]); w.w = pk2(r[6], r[7]); *(u32x4*)(Mg + row * 1024 + mcol + bj * 128) = w; }
        }
    }
};
struct EpiResid {
    static constexpr bool PERM = false; float* Z;
    __device__ __forceinline__ void operator()(const f32x4 (&acc)[2][2][4][2], const Unit& u, int wr, int wc, int fr, int fq, LAS unsigned char*) const {
        const int row0 = u.pm * 256 + wr * 64 + fr, col0 = u.pn * 256 + wc * 32 + 4 * fq;
        if (u.aux < 0) {
#pragma unroll
            for (int ai = 0; ai < 2; ++ai) {
                f32x4 zv[4][2][2];
#pragma unroll
                for (int m = 0; m < 4; ++m)
#pragma unroll
                    for (int bj = 0; bj < 2; ++bj)
#pragma unroll
                        for (int n = 0; n < 2; ++n) zv[m][bj][n] = *(const f32x4*)(Z + (size_t)(row0 + ai * 128 + m * 16) * 1024 + col0 + bj * 128 + n * 16);
#pragma unroll
                for (int m = 0; m < 4; ++m)
#pragma unroll
                    for (int bj = 0; bj < 2; ++bj)
#pragma unroll
                        for (int n = 0; n < 2; ++n) *(f32x4*)(Z + (size_t)(row0 + ai * 128 + m * 16) * 1024 + col0 + bj * 128 + n * 16) = zv[m][bj][n] + acc[ai][bj][m][n];
            }
        } else {
#pragma unroll
            for (int ai = 0; ai < 2; ++ai)
#pragma unroll
                for (int m = 0; m < 4; ++m) { float* rowp = Z + (size_t)(row0 + ai * 128 + m * 16) * 1024 + col0;
#pragma unroll
                    for (int bj = 0; bj < 2; ++bj)
#pragma unroll
                        for (int n = 0; n < 2; ++n) { float* p = rowp + bj * 128 + n * 16; const f32x4 v = acc[ai][bj][m][n];
                            unsafeAtomicAdd(p, v[0]); unsafeAtomicAdd(p + 1, v[1]); unsafeAtomicAdd(p + 2, v[2]); unsafeAtomicAdd(p + 3, v[3]); } }
        }
    }
};
struct EpiFFN {
    static constexpr bool PERM = true; bf16_t* Act; const float* cw; const float* cb;
    __device__ __forceinline__ void operator()(f32x4 (&acc)[2][2][4][2], const Unit& u, int wr, int wc, int fr, int fq, LAS unsigned char* lds) const {
        LAS float* xch = (LAS float*)(lds + LDS_XCH);
        const int ccol = wc * 32 + 8 * fq;
        if (fr >= 14) {
#pragma unroll
            for (int ai = 0; ai < 2; ++ai)
#pragma unroll
                for (int bj = 0; bj < 2; ++bj)
#pragma unroll
                    for (int n = 0; n < 2; ++n) *(LAS f32x4*)(xch + ((2 * ai + wr) * 2 + (fr - 14)) * 256 + bj * 128 + ccol + 4 * n) = acc[ai][bj][3][n];
        }
        WG_BAR();
        const int ffbase = u.pn * 128 + ccol;
        const int Rbase = u.pm * 254 - 2 + wr * 64 + fr;
        unsigned mk0 = 0u, mk1 = 0u;
#pragma unroll
        for (int ai = 0; ai < 2; ++ai)
#pragma unroll
            for (int m = 0; m < 4; ++m) { const int tm = (Rbase + ai * 128 + m * 16 + TS) % TS; mk0 |= (tm == 0 ? 1u : 0u) << (4 * ai + m); mk1 |= (tm < 2 ? 1u : 0u) << (4 * ai + m); }
        const bool f0 = fr == 0, f1 = fr == 1;
#pragma unroll
        for (int n = 0; n < 2; ++n) {
            f32x4 cwv[2][4];
#pragma unroll
            for (int bj = 0; bj < 2; ++bj) { const int cc4 = bj * DFF + ffbase + 4 * n;
                cwv[bj][0] = *(const f32x4*)(cw + cc4); cwv[bj][1] = *(const f32x4*)(cw + 2 * DFF + cc4); cwv[bj][2] = *(const f32x4*)(cw + 4 * DFF + cc4); cwv[bj][3] = *(const f32x4*)(cb + cc4); }
#pragma unroll
            for (int e = 0; e < 4; ++e) {
                float cres[2][2][4];
#pragma unroll
                for (int bj = 0; bj < 2; ++bj) {
                    float w0 = cwv[bj][0][e], w1 = cwv[bj][1][e], w2 = cwv[bj][2][e], bb = cwv[bj][3][e];
                    asm volatile("" : "+v"(w0), "+v"(w1), "+v"(w2), "+v"(bb));
#pragma unroll
                    for (int ai = 0; ai < 2; ++ai) {
                        const int seg = 2 * ai + wr, sp = seg > 0 ? seg - 1 : 0;
                        float h0 = xch[(sp * 2 + 0) * 256 + bj * 128 + ccol + 4 * n + e], h1 = xch[(sp * 2 + 1) * 256 + bj * 128 + ccol + 4 * n + e];
                        h0 = seg > 0 ? h0 : 0.f; h1 = seg > 0 ? h1 : 0.f;
                        float a1p = 0.f, a2p = 0.f;
#pragma unroll
                        for (int m = 0; m < 4; ++m) {
                            float uu = acc[ai][bj][m][n][e];
                            asm volatile("" : "+v"(uu));
                            const float a1 = dppf<0x121>(uu), a2 = dppf<0x122>(uu);
                            float p1, p2;
                            if (m == 0) { p1 = f0 ? h1 : a1; p2 = f0 ? h0 : (f1 ? h1 : a2); }
                            else { p1 = f0 ? a1p : a1; p2 = (f0 || f1) ? a2p : a2; }
                            a1p = a1; a2p = a2;
                            p1 = ((mk0 >> (4 * ai + m)) & 1u) ? 0.f : p1; p2 = ((mk1 >> (4 * ai + m)) & 1u) ? 0.f : p2;
                            cres[bj][ai][m] = bb + w0 * p2 + w1 * p1 + w2 * uu;
                        }
                    }
                }
#pragma unroll
                for (int ai = 0; ai < 2; ++ai)
#pragma unroll
                    for (int m = 0; m < 4; ++m) { const float gt = cres[0][ai][m]; float rr = gt * sigmoidf_(gt) * cres[1][ai][m]; asm volatile("" : "+v"(rr)); acc[ai][0][m][n][e] = rr; }
            }
        }
#pragma unroll
        for (int ai = 0; ai < 2; ++ai)
#pragma unroll
            for (int m = 0; m < 4; ++m) {
                const int rl = ai * 128 + wr * 64 + m * 16 + fr; const int R = u.pm * 254 - 2 + rl;
                if (rl >= 2 && R < MROWS) { const f32x4 v0 = acc[ai][0][m][0], v1 = acc[ai][0][m][1];
                    u32x4 w; w.x = pk2(v0[0], v0[1]); w.y = pk2(v0[2], v0[3]); w.z = pk2(v1[0], v1[1]); w.w = pk2(v1[2], v1[3]); *(u32x4*)(Act + (size_t)R * DFF + ffbase) = w; }
            }
    }
};
}

typedef float f32x2v __attribute__((ext_vector_type(2)));
__device__ __forceinline__ int cvt_seg(const float* __restrict__ src, int ldsrc, int col0, bf16_t* __restrict__ dst, int K, int row0, int ncols, int mode, float* tile, int rot) {
    int tid; asm volatile("v_mov_b32 %0, %1" : "=v"(tid) : "v"((int)threadIdx.x));
    const int G = (int)gridDim.x;
    const int nkt = K / 64, njt = (ncols + 255) / 256, nit = nkt * njt;
    const int vb = ((int)blockIdx.x - rot + G) % G;
    const int j4 = tid & 63, k0 = tid >> 6, jj = tid >> 3, kg = tid & 7;
    constexpr int TS_ = 258;
    f32x4 v[8];
#define CVT_LOAD(it_) do { const int kt_ = (it_) % nkt, jt_ = (it_) / nkt, kb_ = kt_ * 64, j_ = jt_ * 256 + 4 * j4; int sc_ = col0 + j_; \
        if (mode == 1) { const int pn_ = j_ >> 8, jl_ = j_ & 255; sc_ = (jl_ < 128) ? 128 * pn_ + jl_ : DFF + 128 * pn_ + (jl_ - 128); } \
        _Pragma("unroll") for (int p = 0; p < 8; ++p) { v[p] = (f32x4){0.f, 0.f, 0.f, 0.f}; if (j_ < ncols) v[p] = *(const f32x4*)(src + (size_t)(kb_ + k0 + 8 * p) * ldsrc + sc_); } } while (0)
    int it = vb;
    if (it < nit) CVT_LOAD(it);
    for (; it < nit; it += G) {
        const int kt = it % nkt, jt = it / nkt, kb = kt * 64, jb = jt * 256;
#pragma unroll
        for (int p = 0; p < 8; ++p) { float* tp = tile + (k0 + 8 * p) * TS_ + 4 * j4; *(f32x2v*)tp = (f32x2v){v[p][0], v[p][1]}; *(f32x2v*)(tp + 2) = (f32x2v){v[p][2], v[p][3]}; }
        __syncthreads();
        if (it + G < nit) CVT_LOAD(it + G);
#pragma unroll
        for (int q = 0; q < 4; ++q) { const int jo = jj + 64 * q;
            if (jb + jo < ncols) { u32x4 w; const float* tp = tile + (8 * kg) * TS_ + jo;
                w.x = pk2(tp[0], tp[TS_]); w.y = pk2(tp[2 * TS_], tp[3 * TS_]); w.z = pk2(tp[4 * TS_], tp[5 * TS_]); w.w = pk2(tp[6 * TS_], tp[7 * TS_]);
                *(u32x4*)(dst + (size_t)(row0 + jb + jo) * K + kb + 8 * kg) = w; } }
        __syncthreads();
    }
#undef CVT_LOAD
    return (rot + nit) % G;
}
__device__ __forceinline__ void convert_weights(const Args& a, int l, unsigned char* wb, float* tile) {
    const float* win = a.in[3] + (size_t)l * 1024 * 8464;
    bf16_t* WIN = (bf16_t*)(wb + WB_WIN);
    int r = 0;
    r = cvt_seg(win, 8464, 0, WIN, 1024, 0, 1024, 0, tile, r);
    r = cvt_seg(win, 8464, 1040, WIN, 1024, 1024, 512, 0, tile, r);
    r = cvt_seg(win, 8464, 1552, WIN, 1024, 1536, 2048, 0, tile, r);
    r = cvt_seg(win, 8464, 6672, WIN, 1024, 3584, 512, 0, tile, r);
    r = cvt_seg(win, 8464, 7248, WIN, 1024, 4096, 1024, 0, tile, r);
    r = cvt_seg(win, 8464, 7184, WIN, 1024, 5120, 64, 0, tile, r);
    r = cvt_seg(win, 8464, 8272, WIN, 1024, 5184, 192, 0, tile, r);
    if (l == 1) r = cvt_seg(a.in[4], 32, 0, WIN, 1024, 5376, 32, 0, tile, r);
    r = cvt_seg(win, 8464, 1024, WIN, 1024, 5408, 16, 0, tile, r);
    r = cvt_seg(win, 8464, 3600, (bf16_t*)(wb + WB_WG), 1024, 0, 3072, 0, tile, r);
    r = cvt_seg(a.in[24] + (size_t)l * 512 * 1024, 1024, 0, (bf16_t*)(wb + WB_WO), 512, 0, 1024, 0, tile, r);
    r = cvt_seg(a.in[25] + (size_t)l * 512 * 1024, 1024, 0, (bf16_t*)(wb + WB_WO) + 1024 * 512, 512, 0, 1024, 0, tile, r);
    r = cvt_seg(a.in[26] + (size_t)l * 512 * 1024, 1024, 0, (bf16_t*)(wb + WB_WO) + 2 * 1024 * 512, 512, 0, 1024, 0, tile, r);
    r = cvt_seg(a.in[27] + (size_t)l * 1024 * 1024, 1024, 0, (bf16_t*)(wb + WB_WOUT), 1024, 0, 1024, 0, tile, r);
    r = cvt_seg(a.in[29] + (size_t)l * 1024 * 5632, 5632, 0, (bf16_t*)(wb + WB_WUP), 1024, 0, 5632, 1, tile, r);
    r = cvt_seg(a.in[32] + (size_t)l * DFF * 1024, 1024, 0, (bf16_t*)(wb + WB_WDN), DFF, 0, 1024, 0, tile, r);
}
__device__ __forceinline__ void norm_rows(int mode, const float* x, const float* meta, float* z, const float* w, bf16_t* h, float* out) {
    int tid; asm volatile("v_mov_b32 %0, %1" : "=v"(tid) : "v"((int)threadIdx.x));
    const int lane = tid & 63, wave = tid >> 6;
    f32x4 wv[4];
#pragma unroll
    for (int i = 0; i < 4; ++i) wv[i] = *(const f32x4*)(w + lane * 4 + 256 * i);
    constexpr int RB = 4;
    for (int row0 = (blockIdx.x * 8 + wave) * RB; row0 < MROWS; row0 += gridDim.x * 8 * RB) {
        f32x4 v[RB][4];
#pragma unroll
        for (int r = 0; r < RB; ++r) {
            const int row = row0 + r, b = row / TS, t = row - b * TS;
            const float* src = (mode == 0) ? (t < 16 ? meta + (size_t)t * 1024 : x + ((size_t)b * 2048 + (t - 16)) * 1024) : z + (size_t)row * 1024;
#pragma unroll
            for (int i = 0; i < 4; ++i) v[r][i] = *(const f32x4*)(src + lane * 4 + 256 * i);
        }
#pragma unroll
        for (int r = 0; r < RB; ++r) {
            const int row = row0 + r, b = row / TS, t = row - b * TS;
            float ss = 0.f;
#pragma unroll
            for (int i = 0; i < 4; ++i) ss += v[r][i][0] * v[r][i][0] + v[r][i][1] * v[r][i][1] + v[r][i][2] * v[r][i][2] + v[r][i][3] * v[r][i][3];
            ss = wave_sum(ss);
            const float rstd = __builtin_amdgcn_rsqf(ss * (1.0f / 1024.0f) + 1e-6f);
            if (mode == 2 && t < 16) continue;
#pragma unroll
            for (int i = 0; i < 4; ++i) {
                if (mode == 0) *(f32x4*)(z + (size_t)row * 1024 + lane * 4 + 256 * i) = v[r][i];
                const f32x4 y = v[r][i] * rstd * wv[i];
                if (mode == 2) *(f32x4*)(out + ((size_t)b * 2048 + (t - 16)) * 1024 + lane * 4 + 256 * i) = y;
                else { u32x2 p; p.x = pk2(y[0], y[1]); p.y = pk2(y[2], y[3]); *(u32x2*)(h + (size_t)row * 1024 + lane * 4 + 256 * i) = p; }
            }
        }
    }
}

__device__ __forceinline__ f32x4 mfma16(bf16x8 a, bf16x8 b, f32x4 c) { return __builtin_amdgcn_mfma_f32_16x16x32_bf16(a, b, c, 0, 0, 0); }
template <int DK, bool HG>
__device__ __forceinline__ void gla_unit(unsigned char* lds, bf16_t* P, int b, int h, int layer, const Args& a, bool st = true) {
    constexpr int NG = 512 / DK, RPG = 32 / NG, LQ = DK + 8, NA = DK / 16;
    bf16_t* RAWQ = (bf16_t*)lds; bf16_t* RAWK = RAWQ + 32 * DK; bf16_t* RAWV = RAWK + 32 * DK; bf16_t* RAWX = RAWV + 32 * 128;
    bf16_t* QT = RAWX + 32 * 16; bf16_t* KT = QT + 32 * LQ; bf16_t* QH = KT + 32 * LQ; bf16_t* KHT = QH + 32 * LQ; bf16_t* VT = KHT + DK * 40; bf16_t* SC = VT + 128 * 40;
    float* DEC = (float*)(SC + 32 * 40); float* TOT = DEC + DK; float* RED = TOT + NG * DK;
    int tid; asm volatile("v_mov_b32 %0, %1" : "=v"(tid) : "v"((int)threadIdx.x));
    const int lane = tid & 63, w = tid >> 6, l16 = lane & 15, g4 = lane >> 4;
    const int qcol = HG ? PC_HQ + 128 * h : PC_GQ + 64 * h, kcol = HG ? PC_HF + 128 * h : PC_GK + 64 * h, vcol = HG ? PC_HI + 128 * h : PC_GV + 128 * h, gcol = HG ? PC_HG + 128 * h : PC_GG + 128 * h;
    const size_t rowbase = (size_t)b * TS;
    const int d = tid % DK, rg = tid / DK;
    float lb = 0.f, up[16], bias = 0.f;
    if (HG) { if (layer == 1) { const float l0 = a.in[22][h * 128 + d], l1 = a.in[22][512 + h * 128 + d]; lb = sigmoidf_(l1 - l0); } }
    else {
#pragma unroll
        for (int j = 0; j < 16; ++j) up[j] = a.in[7][(size_t)layer * 16 * 256 + j * 256 + 64 * h + d];
        bias = a.in[8][layer * 256 + 64 * h + d];
    }
    const float onemlb = 1.0f - lb;
    const float nw = (HG ? a.in[23] : a.in[9])[layer * 128 + 16 * w + l16];
    f32x4 S[NA];
#pragma unroll
    for (int i = 0; i < NA; ++i) S[i] = (f32x4){0.f, 0.f, 0.f, 0.f};
    constexpr int QP = DK / 8;
    const bool hasq = tid < 32 * QP;
    const int qrow = tid / QP, qcg = tid % QP, vrow = tid >> 4, vcg = tid & 15;
    u32x4 rq, rk, rv, rx;
    unsigned short gpre[8], gcur[8];
#pragma unroll
    for (int i = 0; i < 8; ++i) { gpre[i] = 0; gcur[i] = 0; }
    unsigned short fv[8];
#pragma unroll
    for (int i = 0; i < 8; ++i) fv[i] = 0;
    auto load_chunk = [&](int n) {
        const u32x4 zz = (u32x4){0u, 0u, 0u, 0u}; rq = zz; rk = zz; rv = zz; rx = zz;
        if (hasq) { const int t = 32 * n + qrow - 16; if (t >= 0) { const bf16_t* rp = P + (rowbase + t) * LDP; rq = *(const u32x4*)(rp + qcol + 8 * qcg); if (!HG) rk = *(const u32x4*)(rp + kcol + 8 * qcg); } }
        if (HG) {
#pragma unroll
            for (int r = 0; r < 8; ++r) { const int t = 32 * n + (rg * 8 + r) - 16; fv[r] = 0; if (t >= 0) fv[r] = P[(rowbase + t) * LDP + kcol + d]; }
        }
        { const int t = 32 * n + vrow - 16; if (t >= 0) rv = *(const u32x4*)(P + (rowbase + t) * LDP + vcol + 8 * vcg); }
        if (!HG && tid < 64) { const int t = 32 * n + (tid >> 1) - 16; if (t >= 0) rx = *(const u32x4*)(P + (rowbase + t) * LDP + PC_GGK + 8 * (tid & 1)); }
#pragma unroll
        for (int i = 0; i < 8; ++i) { const int t = 32 * n + 16 * (i >> 2) + 4 * g4 + (i & 3) - 16; gpre[i] = 0; if (t >= 0) gpre[i] = P[(rowbase + t) * LDP + gcol + 16 * w + l16]; }
    };
    load_chunk(0);
    for (int n = 0; n < 65; ++n) {
        if (hasq) { *(u32x4*)(RAWQ + qrow * DK + 8 * qcg) = rq; if (!HG) *(u32x4*)(RAWK + qrow * DK + 8 * qcg) = rk; }
        *(u32x4*)(RAWV + vrow * 128 + 8 * vcg) = rv;
        if (!HG && tid < 64) *(u32x4*)(RAWX + (tid >> 1) * 16 + 8 * (tid & 1)) = rx;
        if (!HG) __syncthreads();
#pragma unroll
        for (int i = 0; i < 8; ++i) gcur[i] = gpre[i];
        if (!HG) { if (n + 1 < 65) load_chunk(n + 1); }
        float cum[RPG], kv[RPG]; float run = 0.f;
#pragma unroll
        for (int r = 0; r < RPG; ++r) {
            const int i = rg * RPG + r; const bool valid = (n > 0) || (i >= 16);
            float gg, kk;
            if (HG) { const float zf = bf2f(fv[r]); const float ez = __expf(fminf(-zf, 80.f)); const float sg = __builtin_amdgcn_rcpf(1.0f + ez); gg = logfast_(fmaxf(lb + onemlb * sg, 1e-30f)); kk = onemlb * ez * sg; }
            else { float xx = bias;
                const u32x4 g0 = *(const u32x4*)(RAWX + i * 16), g1 = *(const u32x4*)(RAWX + i * 16 + 8);
                xx += bflo(g0.x) * up[0] + bfhi(g0.x) * up[1] + bflo(g0.y) * up[2] + bfhi(g0.y) * up[3] + bflo(g0.z) * up[4] + bfhi(g0.z) * up[5] + bflo(g0.w) * up[6] + bfhi(g0.w) * up[7];
                xx += bflo(g1.x) * up[8] + bfhi(g1.x) * up[9] + bflo(g1.y) * up[10] + bfhi(g1.y) * up[11] + bflo(g1.z) * up[12] + bfhi(g1.z) * up[13] + bflo(g1.w) * up[14] + bfhi(g1.w) * up[15];
                gg = -softplusf_(-xx) * (1.0f / 16.0f); kk = bf2f(RAWK[i * DK + d]); }
            if (!valid) { gg = 0.f; kk = 0.f; }
            run += gg; cum[r] = run; kv[r] = kk;
        }
        if (HG) { if (n + 1 < 65) load_chunk(n + 1); }
        TOT[rg * DK + d] = run;
        __syncthreads();
        {
            float off = 0.f, bref = 0.f, blast = 0.f;
#pragma unroll
            for (int q = 0; q < NG; ++q) { const float tq = TOT[q * DK + d]; if (q < rg) off += tq; if (q < NG / 2) bref += tq; blast += tq; }
            unsigned short kh[RPG];
            const float ebref = __expf(bref), ebl = __expf(blast - bref);
#pragma unroll
            for (int r = 0; r < RPG; ++r) {
                const int i = rg * RPG + r; const float bb = off + cum[r];
                const float qv = bf2f(RAWQ[i * DK + d]) * (HG ? 1.0f : 0.125f);
                const float e1 = __expf(bb - bref), e2 = __builtin_amdgcn_rcpf(e1);
                const float qt = qv * e1, kt = kv[r] * e2;
                const unsigned p1 = pk2(qt, kt), p2 = pk2(qt * ebref, kt * ebl);
                QT[i * LQ + d] = (bf16_t)(p1 & 0xffffu); KT[i * LQ + d] = (bf16_t)(p1 >> 16);
                QH[i * LQ + d] = (bf16_t)(p2 & 0xffffu); kh[r] = (unsigned short)(p2 >> 16);
            }
            if (RPG == 8) { u32x4 wv; wv.x = kh[0] | ((unsigned)kh[1] << 16); wv.y = kh[2] | ((unsigned)kh[3] << 16); wv.z = kh[4 % RPG] | ((unsigned)kh[5 % RPG] << 16); wv.w = kh[6 % RPG] | ((unsigned)kh[7 % RPG] << 16); *(u32x4*)(KHT + d * 40 + rg * 8) = wv; }
            else { u32x2 wv; wv.x = kh[0] | ((unsigned)kh[1] << 16); wv.y = kh[2] | ((unsigned)kh[3] << 16); *(u32x2*)(KHT + d * 40 + rg * 4) = wv; }
            if (rg == 0) DEC[d] = __expf(blast);
            const int dv = tid & 127, rgv = tid >> 7;
            unsigned short vv[8];
#pragma unroll
            for (int r = 0; r < 8; ++r) vv[r] = RAWV[(8 * rgv + r) * 128 + dv];
            u32x4 wv; wv.x = vv[0] | ((unsigned)vv[1] << 16); wv.y = vv[2] | ((unsigned)vv[3] << 16); wv.z = vv[4] | ((unsigned)vv[5] << 16); wv.w = vv[6] | ((unsigned)vv[7] << 16);
            *(u32x4*)(VT + dv * 40 + 8 * rgv) = wv;
        }
        __syncthreads();
        if (w < 4) {
            const int ri = w >> 1, cj = w & 1; f32x4 s = (f32x4){0.f, 0.f, 0.f, 0.f};
            if (!(ri == 0 && cj == 1)) {
#pragma unroll
                for (int ks = 0; ks < DK / 32; ++ks) { const bf16x8 A = *(const bf16x8*)(QT + (16 * ri + l16) * LQ + 32 * ks + 8 * g4); const bf16x8 B = *(const bf16x8*)(KT + (16 * cj + l16) * LQ + 32 * ks + 8 * g4); s = mfma16(A, B, s); }
            }
#pragma unroll
            for (int e = 0; e < 4; ++e) { const int i = 16 * ri + 4 * g4 + e, j = 16 * cj + l16; SC[i * 40 + j] = (bf16_t)f2bf(i >= j ? s[e] : 0.f); }
        }
        f32x4 O[2];
        {
            bf16x4 qlo[2][DK / 32], qhi[2][DK / 32];
#pragma unroll
            for (int rt = 0; rt < 2; ++rt)
#pragma unroll
                for (int ks = 0; ks < DK / 32; ++ks) { qlo[rt][ks] = *(const bf16x4*)(QH + (16 * rt + l16) * LQ + 32 * ks + 4 * g4); qhi[rt][ks] = *(const bf16x4*)(QH + (16 * rt + l16) * LQ + 32 * ks + 16 + 4 * g4); }
            O[0] = (f32x4){0.f, 0.f, 0.f, 0.f}; O[1] = O[0];
#pragma unroll
            for (int ks = 0; ks < DK / 32; ++ks) {
                const bf16x8 B = pk8(S[2 * ks], S[2 * ks + 1]);
#pragma unroll
                for (int rt = 0; rt < 2; ++rt) O[rt] = mfma16(__builtin_shufflevector(qlo[rt][ks], qhi[rt][ks], 0, 1, 2, 3, 4, 5, 6, 7), B, O[rt]);
            }
        }
        __syncthreads();
        {
            const bf16x8 Bv = *(const bf16x8*)(VT + (16 * w + l16) * 40 + 8 * g4);
#pragma unroll
            for (int rt = 0; rt < 2; ++rt) { const bf16x8 A = *(const bf16x8*)(SC + (16 * rt + l16) * 40 + 8 * g4); O[rt] = mfma16(A, Bv, O[rt]); }
#pragma unroll
            for (int ib = 0; ib < NA; ib += 4) {
                f32x4 dcv[4]; bf16x8 khv[4];
#pragma unroll
                for (int j = 0; j < 4; ++j) { dcv[j] = *(const f32x4*)(DEC + 16 * (ib + j) + 4 * g4); khv[j] = *(const bf16x8*)(KHT + (16 * (ib + j) + l16) * 40 + 8 * g4); }
#pragma unroll
                for (int j = 0; j < 4; ++j) { S[ib + j] = S[ib + j] * dcv[j]; S[ib + j] = mfma16(khv[j], Bv, S[ib + j]); }
            }
#pragma unroll
            for (int rt = 0; rt < 2; ++rt)
#pragma unroll
                for (int e = 0; e < 4; ++e) { const float sq = red16(O[rt][e] * O[rt][e]); if (l16 == 0) RED[w * 32 + 16 * rt + 4 * g4 + e] = sq; }
        }
        __syncthreads();
#pragma unroll
        for (int rt = 0; rt < 2; ++rt) {
            f32x4 tot4 = *(const f32x4*)(RED + 16 * rt + 4 * g4);
#pragma unroll
            for (int q = 1; q < 8; ++q) tot4 = tot4 + *(const f32x4*)(RED + q * 32 + 16 * rt + 4 * g4);
#pragma unroll
            for (int e = 0; e < 4; ++e) {
                const int i = 16 * rt + 4 * g4 + e, t = 32 * n + i - 16;
                const float rstd = __builtin_amdgcn_rsqf(tot4[e] * (1.0f / 128.0f) + 1e-6f);
                if (t >= 0 && st) { bf16_t* gp = P + (rowbase + t) * LDP + gcol + 16 * w + l16; const float gt = bf2f(gcur[4 * rt + e]); *gp = (bf16_t)f2bf(O[rt][e] * rstd * nw * gt * sigmoidf_(gt)); }
            }
        }
    }
}

__device__ __forceinline__ bf16x8 load_bfrag(const float* W, int s, int g4, int C) {
    bf16x8 r;
#pragma unroll
    for (int j = 0; j < 8; ++j) r[j] = (short)f2bf(W[(size_t)(32 * s + 8 * g4 + j) * 512 + C]);
    return r;
}
__device__ __forceinline__ void rwkv_unit(unsigned char* lds, bf16_t* P, bf16_t* VF, int b, int h, int layer, const Args& a, bool st = true) {
    bf16_t* SW = (bf16_t*)lds; bf16_t* SA = SW + 32 * 72; bf16_t* SG = SA + 32 * 72; bf16_t* SVR = SG + 32 * 136;
    constexpr int FS = 68; float* LG = (float*)(SVR + 32 * 40); float* GG = LG + 32 * FS; float* AA = GG + 32 * FS; float* VG = AA + 32 * FS; float* Y = VG + 32 * FS;
    float* BON = Y + 32 * FS; float* GC = BON + 32; float* LAB = GC + 128; float* CST = LAB + 512;
    bf16_t* Abf = (bf16_t*)(CST + 800); bf16_t* Qbf = Abf + 32 * 72; bf16_t* Bbf = Qbf + 32 * 72; bf16_t* Cbf = Bbf + 32 * 72;
    constexpr int LT = 36; bf16_t* BT = Cbf + 32 * 72; bf16_t* CT = BT + 64 * LT; bf16_t* VmT = CT + 64 * LT;
    bf16_t* LAC = VmT + 64 * LT + 64; bf16_t* MQB = LAC + 512; bf16_t* MQC = MQB + 512; bf16_t* TT = MQC + 512;
    constexpr int RS = 488;
    bf16_t* RAWC = TT + 512; bf16_t* CARRY = RAWC + 32 * RS;
    int tid; asm volatile("v_mov_b32 %0, %1" : "=v"(tid) : "v"((int)threadIdx.x));
    const int lane = tid & 63, w = tid >> 6, l16 = lane & 15, g4 = lane >> 4;
    const size_t rowbase = (size_t)b * TS;
    const int ti = tid >> 4, q = tid & 15, C4 = 64 * h + 4 * q;
    {
        const float* mu = a.in[5] + (size_t)layer * 1792;
        if (tid < 64) { const int C = 64 * h + tid;
            CST[tid] = mu[C]; CST[64 + tid] = mu[576 + C]; CST[128 + tid] = mu[1088 + C];
            CST[192 + tid] = a.in[17][layer * 512 + C]; CST[256 + tid] = a.in[18][layer * 512 + C]; CST[320 + tid] = a.in[19][layer * 512 + C];
            CST[384 + tid] = a.in[20][layer * 512 + C]; CST[448 + tid] = a.in[21][layer * 512 + C];
            CST[512 + tid] = mu[512 + tid]; CST[576 + tid] = mu[1600 + tid]; }
        if (tid < 128) CST[640 + tid] = mu[1664 + tid];
        if (tid < 32) CST[768 + tid] = (layer == 1) ? a.in[6][tid] : 0.f;
    }
    const int rt = w >> 2, ct = w & 3, Cm = 64 * h + 16 * ct + l16;
    bf16x8 Bw[2], Ba[2], Bg[4], Bvr;
#pragma unroll
    for (int s = 0; s < 2; ++s) { Bw[s] = load_bfrag(a.in[11] + (size_t)layer * 64 * 512, s, g4, Cm); Ba[s] = load_bfrag(a.in[13] + (size_t)layer * 64 * 512, s, g4, Cm); }
#pragma unroll
    for (int s = 0; s < 4; ++s) Bg[s] = load_bfrag(a.in[16] + (size_t)layer * 128 * 512, s, g4, Cm);
    Bvr = (bf16x8){0, 0, 0, 0, 0, 0, 0, 0};
    float v0c = 0.f;
    if (layer == 1) { Bvr = load_bfrag(a.in[15], 0, g4, Cm); v0c = a.in[14][Cm]; }
    const float w0c = a.in[10][layer * 512 + Cm], a0c = a.in[12][layer * 512 + Cm];
    f32x4 ST[4];
#pragma unroll
    for (int j = 0; j < 4; ++j) ST[j] = (f32x4){0.f, 0.f, 0.f, 0.f};
    u32x2 n_r, n_k, n_v, n_w, n_a, n_vf; u32x4 n_g; unsigned n_vr;
#define RW_LOAD_RAW(cc) do { const int t_ = 32 * (cc) + ti; const u32x2 z2_ = (u32x2){0u, 0u}; n_r = z2_; n_k = z2_; n_v = z2_; n_w = z2_; n_a = z2_; n_vf = z2_; n_g = (u32x4){0u, 0u, 0u, 0u}; n_vr = 0u; \
        if (t_ < TS) { const bf16_t* rp_ = P + (rowbase + t_) * LDP; n_r = *(const u32x2*)(rp_ + PC_RR + C4); n_k = *(const u32x2*)(rp_ + PC_RK + C4); n_v = *(const u32x2*)(rp_ + PC_RV + C4); \
            n_w = *(const u32x2*)(rp_ + PC_RW + 4 * q); n_a = *(const u32x2*)(rp_ + PC_RA + 4 * q); n_g = *(const u32x4*)(rp_ + PC_RG + 8 * q); n_vr = *(const unsigned*)(rp_ + PC_RVR + 2 * q); \
            if (layer == 1) n_vf = *(const u32x2*)(VF + (rowbase + t_) * 512 + C4); } } while (0)
#define BF4(u) ((f32x4){bflo((u).x), bfhi((u).x), bflo((u).y), bfhi((u).y)})
    RW_LOAD_RAW(0);

    for (int c = 0; c < 65; ++c) {
        const int t0 = 32 * c, t = t0 + ti; const bool valid = t < TS;
        f32x4 r4 = (f32x4){0.f, 0.f, 0.f, 0.f}, k4 = r4, v4 = r4, vf4 = r4;
        {
            bf16_t* rw = RAWC + ti * RS;
            *(u32x2*)(rw + 4 * q) = n_r; *(u32x2*)(rw + 64 + 4 * q) = n_k; *(u32x2*)(rw + 128 + 4 * q) = n_v; *(u32x2*)(rw + 192 + 4 * q) = n_w; *(u32x2*)(rw + 256 + 4 * q) = n_a;
            *(u32x4*)(rw + 320 + 8 * q) = n_g; *(unsigned*)(rw + 448 + 2 * q) = n_vr;
            if (ti == 31) { bf16_t* cw_ = CARRY + (c & 1) * RS;
                *(u32x2*)(cw_ + 4 * q) = n_r; *(u32x2*)(cw_ + 64 + 4 * q) = n_k; *(u32x2*)(cw_ + 128 + 4 * q) = n_v; *(u32x2*)(cw_ + 192 + 4 * q) = n_w; *(u32x2*)(cw_ + 256 + 4 * q) = n_a;
                *(u32x4*)(cw_ + 320 + 8 * q) = n_g; *(unsigned*)(cw_ + 448 + 2 * q) = n_vr; }
            vf4 = BF4(n_vf);
        }
        __syncthreads();
        if (c + 1 < 65) RW_LOAD_RAW(c + 1);
        {
            const bf16_t* cu = RAWC + ti * RS; const bf16_t* pv = (ti > 0) ? cu - RS : CARRY + ((c + 1) & 1) * RS;
            const bool hasprev = t > 0;
            f32x4 sw = r4, sa = r4, sg0 = r4, sg1 = r4; float sv0 = 0.f, sv1 = 0.f;
            if (valid) {
                const u32x2 z2 = (u32x2){0u, 0u};
                const u32x2 cr = *(const u32x2*)(cu + 4 * q), ck = *(const u32x2*)(cu + 64 + 4 * q), cv = *(const u32x2*)(cu + 128 + 4 * q), cwv = *(const u32x2*)(cu + 192 + 4 * q), cav = *(const u32x2*)(cu + 256 + 4 * q);
                const u32x4 cgv = *(const u32x4*)(cu + 320 + 8 * q); const unsigned cvr = *(const unsigned*)(cu + 448 + 2 * q);
                u32x2 pr = z2, pk = z2, pvv = z2, pwv = z2, pav = z2; u32x4 pgv = (u32x4){0u, 0u, 0u, 0u}; unsigned pvr = 0u;
                if (hasprev) { pr = *(const u32x2*)(pv + 4 * q); pk = *(const u32x2*)(pv + 64 + 4 * q); pvv = *(const u32x2*)(pv + 128 + 4 * q); pwv = *(const u32x2*)(pv + 192 + 4 * q); pav = *(const u32x2*)(pv + 256 + 4 * q);
                    pgv = *(const u32x4*)(pv + 320 + 8 * q); pvr = *(const unsigned*)(pv + 448 + 2 * q); }
                const f32x4 mu_r = *(const f32x4*)(CST + 4 * q), mu_k = *(const f32x4*)(CST + 64 + 4 * q), mu_v = *(const f32x4*)(CST + 128 + 4 * q);
                const f32x4 mu_w = *(const f32x4*)(CST + 512 + 4 * q), mu_a = *(const f32x4*)(CST + 576 + 4 * q), mu_g0 = *(const f32x4*)(CST + 640 + 8 * q), mu_g1 = *(const f32x4*)(CST + 644 + 8 * q);
                const float mu_vr0 = CST[768 + 2 * q], mu_vr1 = CST[769 + 2 * q];
                const f32x4 crf = BF4(cr), prf = BF4(pr); r4 = crf + (prf - crf) * mu_r;
                const f32x4 ckf = BF4(ck), pkf = BF4(pk); k4 = ckf + (pkf - ckf) * mu_k;
                const f32x4 cvf = BF4(cv), pvf = BF4(pvv); v4 = cvf + (pvf - cvf) * mu_v;
                const f32x4 cwf = BF4(cwv), pwf = BF4(pwv); sw = cwf + (pwf - cwf) * mu_w;
                const f32x4 caf = BF4(cav), paf = BF4(pav); sa = caf + (paf - caf) * mu_a;
                const f32x4 cg0 = (f32x4){bflo(cgv.x), bfhi(cgv.x), bflo(cgv.y), bfhi(cgv.y)}, pg0 = (f32x4){bflo(pgv.x), bfhi(pgv.x), bflo(pgv.y), bfhi(pgv.y)};
                const f32x4 cg1 = (f32x4){bflo(cgv.z), bfhi(cgv.z), bflo(cgv.w), bfhi(cgv.w)}, pg1 = (f32x4){bflo(pgv.z), bfhi(pgv.z), bflo(pgv.w), bfhi(pgv.w)};
                sg0 = cg0 + (pg0 - cg0) * mu_g0; sg1 = cg1 + (pg1 - cg1) * mu_g1;
                sv0 = bflo(cvr) + (bflo(pvr) - bflo(cvr)) * mu_vr0; sv1 = bfhi(cvr) + (bfhi(pvr) - bfhi(cvr)) * mu_vr1;
            }
            u32x2 o; o.x = pk2(tanhf_(sw[0]), tanhf_(sw[1])); o.y = pk2(tanhf_(sw[2]), tanhf_(sw[3])); *(u32x2*)(SW + ti * 72 + 4 * q) = o;
            o.x = pk2(sa[0], sa[1]); o.y = pk2(sa[2], sa[3]); *(u32x2*)(SA + ti * 72 + 4 * q) = o;
            u32x4 og; og.x = pk2(sigmoidf_(sg0[0]), sigmoidf_(sg0[1])); og.y = pk2(sigmoidf_(sg0[2]), sigmoidf_(sg0[3])); og.z = pk2(sigmoidf_(sg1[0]), sigmoidf_(sg1[1])); og.w = pk2(sigmoidf_(sg1[2]), sigmoidf_(sg1[3]));
            *(u32x4*)(SG + ti * 136 + 8 * q) = og;
            *(unsigned*)(SVR + ti * 40 + 2 * q) = (layer == 1) ? pk2(sv0, sv1) : 0u;
        }
        __syncthreads();
        {
            f32x4 cw = (f32x4){0.f, 0.f, 0.f, 0.f}, ca = cw, cgt = cw, cvv = cw;
#pragma unroll
            for (int s = 0; s < 2; ++s) { cw = mfma16(*(const bf16x8*)(SW + (16 * rt + l16) * 72 + 32 * s + 8 * g4), Bw[s], cw); ca = mfma16(*(const bf16x8*)(SA + (16 * rt + l16) * 72 + 32 * s + 8 * g4), Ba[s], ca); }
#pragma unroll
            for (int s = 0; s < 4; ++s) cgt = mfma16(*(const bf16x8*)(SG + (16 * rt + l16) * 136 + 32 * s + 8 * g4), Bg[s], cgt);
            if (layer == 1) cvv = mfma16(*(const bf16x8*)(SVR + (16 * rt + l16) * 40 + 8 * g4), Bvr, cvv);
            float lw[4];
#pragma unroll
            for (int e = 0; e < 4; ++e) {
                const int idx = (16 * rt + 4 * g4 + e) * FS + 16 * ct + l16;
                const float wl = -softplusf_(-(w0c + cw[e])) - 0.5f;
                lw[e] = (t0 + 16 * rt + 4 * g4 + e < TS) ? -__expf(wl) : 0.f;
                AA[idx] = sigmoidf_(a0c + ca[e]); GG[idx] = cgt[e]; VG[idx] = sigmoidf_(v0c + cvv[e]);
            }
            lw[1] += lw[0]; lw[2] += lw[1]; lw[3] += lw[2];
            float run = lw[3];
            { const float u1 = __shfl_up(run, 16, 64); if (g4 >= 1) run += u1; const float u2 = __shfl_up(run, 32, 64); if (g4 >= 2) run += u2; }
            const float excl = run - lw[3];
#pragma unroll
            for (int e = 0; e < 4; ++e) LG[(16 * rt + 4 * g4 + e) * FS + 16 * ct + l16] = excl + lw[e];
        }
        __syncthreads();
        {
            const f32x4 a4 = *(const f32x4*)(AA + ti * FS + 4 * q);
            if (layer == 1) { const f32x4 vg = *(const f32x4*)(VG + ti * FS + 4 * q); v4 = v4 + (vf4 - v4) * vg; }
            else if (valid && st) { u32x2 o; o.x = pk2(v4[0], v4[1]); o.y = pk2(v4[2], v4[3]); *(u32x2*)(VF + (rowbase + t) * 512 + C4) = o; }
            const f32x4 kkw = *(const f32x4*)(CST + 192 + 4 * q), kaw = *(const f32x4*)(CST + 256 + 4 * q), rkw = *(const f32x4*)(CST + 320 + 4 * q);
            f32x4 kk = k4 * kkw;
            const float ss = red16(kk[0] * kk[0] + kk[1] * kk[1] + kk[2] * kk[2] + kk[3] * kk[3]);
            kk = kk * fminf(__builtin_amdgcn_rsqf(ss), 1e12f);
            const f32x4 kp = k4 * (1.0f + (a4 - 1.0f) * kaw);
            const f32x4 rkp = r4 * kp * rkw;
            const float bon = red16(rkp[0] + rkp[1] + rkp[2] + rkp[3]);
            if (q == 0) BON[ti] = bon;
            const f32x4 lg = *(const f32x4*)(LG + ti * FS + 4 * q);
            f32x4 lgp = (f32x4){0.f, 0.f, 0.f, 0.f}; if ((ti & 15) != 0) lgp = *(const f32x4*)(LG + (ti - 1) * FS + 4 * q);
            f32x4 eg, egi, egp;
#pragma unroll
            for (int j = 0; j < 4; ++j) { eg[j] = __expf(lg[j]); egi[j] = __builtin_amdgcn_rcpf(eg[j]); egp[j] = __expf(lgp[j]); }
            f32x4 av = -(kk * egp), bv = kk * a4 * egi, cv = kp * egi, qv = r4 * eg, vv = v4;
            if (!valid) { const f32x4 zz = (f32x4){0.f, 0.f, 0.f, 0.f}; av = zz; bv = zz; cv = zz; qv = zz; vv = zz; }
            u32x2 o;
            o.x = pk2(av[0], av[1]); o.y = pk2(av[2], av[3]); *(u32x2*)(Abf + ti * 72 + 4 * q) = o;
            o.x = pk2(qv[0], qv[1]); o.y = pk2(qv[2], qv[3]); *(u32x2*)(Qbf + ti * 72 + 4 * q) = o;
            o.x = pk2(bv[0], bv[1]); o.y = pk2(bv[2], bv[3]); *(u32x2*)(Bbf + ti * 72 + 4 * q) = o;
#pragma unroll
            for (int j = 0; j < 4; ++j) BT[(4 * q + j) * LT + ti] = (bf16_t)(j & 1 ? (j == 1 ? o.x >> 16 : o.y >> 16) : (j == 0 ? o.x & 0xffffu : o.y & 0xffffu));
            o.x = pk2(cv[0], cv[1]); o.y = pk2(cv[2], cv[3]); *(u32x2*)(Cbf + ti * 72 + 4 * q) = o;
#pragma unroll
            for (int j = 0; j < 4; ++j) CT[(4 * q + j) * LT + ti] = (bf16_t)(j & 1 ? (j == 1 ? o.x >> 16 : o.y >> 16) : (j == 0 ? o.x & 0xffffu : o.y & 0xffffu));
            o.x = pk2(vv[0], vv[1]); o.y = pk2(vv[2], vv[3]);
#pragma unroll
            for (int j = 0; j < 4; ++j) VmT[(4 * q + j) * LT + ti] = (bf16_t)(j & 1 ? (j == 1 ? o.x >> 16 : o.y >> 16) : (j == 0 ? o.x & 0xffffu : o.y & 0xffffu));
            if ((ti & 15) == 15) *(f32x4*)(GC + (ti >> 4) * 64 + 4 * q) = eg;
        }
        __syncthreads();
        {
            const int sc = w >> 2, mat = w & 3;
            const bf16_t* X = (mat < 2 ? Abf : Qbf) + (16 * sc + l16) * 72; const bf16_t* Yp = ((mat & 1) ? Cbf : Bbf) + (16 * sc + l16) * 72;
            f32x4 d = (f32x4){0.f, 0.f, 0.f, 0.f};
#pragma unroll
            for (int s = 0; s < 2; ++s) d = mfma16(*(const bf16x8*)(X + 32 * s + 8 * g4), *(const bf16x8*)(Yp + 32 * s + 8 * g4), d);
            if (mat != 0) {
#pragma unroll
                for (int e = 0; e < 4; ++e) {
                    const int tt = 4 * g4 + e, ii = l16;
                    const bool keep = (mat < 2) ? (ii < tt) : (ii <= tt);
                    bf16_t* D = (mat == 1 ? LAC : (mat == 2 ? MQB : MQC)); D[sc * 256 + tt * 16 + ii] = (bf16_t)f2bf(keep ? d[e] : 0.f);
                }
            } else {
                f32x4 dT = (f32x4){0.f, 0.f, 0.f, 0.f};
#pragma unroll
                for (int s = 0; s < 2; ++s) dT = mfma16(*(const bf16x8*)(Yp + 32 * s + 8 * g4), *(const bf16x8*)(X + 32 * s + 8 * g4), dT);
                f32x4 X1, X1T, eye;
#pragma unroll
                for (int e = 0; e < 4; ++e) { const int r = 4 * g4 + e; X1[e] = (l16 < r) ? d[e] : 0.f; X1T[e] = (r < l16) ? dT[e] : 0.f; eye[e] = (r == l16) ? 1.f : 0.f; }
#define OPND(m) __builtin_bit_cast(bf16x8, ((u32x4){pk2((m)[0], (m)[1]), pk2((m)[2], (m)[3]), 0u, 0u}))
                const f32x4 zz = (f32x4){0.f, 0.f, 0.f, 0.f};
                const bf16x8 o1 = OPND(X1), o1t = OPND(X1T);
                const f32x4 X2 = mfma16(o1t, o1, zz), X2T = mfma16(o1, o1t, zz);
                const bf16x8 o2 = OPND(X2), o2t = OPND(X2T);
                const f32x4 X4 = mfma16(o2t, o2, zz), X4T = mfma16(o2, o2t, zz);
                const bf16x8 o4 = OPND(X4), o4t = OPND(X4T);
                const f32x4 X8 = mfma16(o4t, o4, zz);
                const f32x4 i2 = X2 + eye, i1t = X1T + eye, i4 = X4 + eye, i8 = X8 + eye;
                const f32x4 R1 = mfma16(OPND(i2), OPND(i1t), zz);
                const f32x4 R2 = mfma16(OPND(i4), OPND(R1), zz);
                const f32x4 R3 = mfma16(OPND(i8), OPND(R2), zz);
#undef OPND
                u32x2 o; o.x = pk2(R3[0], R3[1]); o.y = pk2(R3[2], R3[3]); *(u32x2*)(TT + sc * 256 + l16 * 16 + 4 * g4) = o;
            }
        }
        __syncthreads();
        if (w < 4) {
            const int nsc = (TS - t0) >= 32 ? 2 : 1;
            const bf16x4 z4 = (bf16x4){0, 0, 0, 0};
            for (int sc = 0; sc < nsc; ++sc) {
                const int tr = 16 * sc + l16;
                bf16x4 alo[2], ahi[2], qlo[2], qhi[2];
#pragma unroll
                for (int s = 0; s < 2; ++s) { alo[s] = *(const bf16x4*)(Abf + tr * 72 + 32 * s + 4 * g4); ahi[s] = *(const bf16x4*)(Abf + tr * 72 + 32 * s + 16 + 4 * g4);
                                              qlo[s] = *(const bf16x4*)(Qbf + tr * 72 + 32 * s + 4 * g4); qhi[s] = *(const bf16x4*)(Qbf + tr * 72 + 32 * s + 16 + 4 * g4); }
                const bf16x4 vm4 = *(const bf16x4*)(VmT + (16 * w + l16) * LT + 16 * sc + 4 * g4);
                const bf16x4 l4 = *(const bf16x4*)(LAC + sc * 256 + l16 * 16 + 4 * g4), t4 = *(const bf16x4*)(TT + sc * 256 + l16 * 16 + 4 * g4);
                const bf16x4 m1 = *(const bf16x4*)(MQB + sc * 256 + l16 * 16 + 4 * g4), m2 = *(const bf16x4*)(MQC + sc * 256 + l16 * 16 + 4 * g4);
                bf16x4 b4[4], c4v[4]; f32x4 gcv[4];
#pragma unroll
                for (int tm = 0; tm < 4; ++tm) { b4[tm] = *(const bf16x4*)(BT + (16 * tm + l16) * LT + 16 * sc + 4 * g4); c4v[tm] = *(const bf16x4*)(CT + (16 * tm + l16) * LT + 16 * sc + 4 * g4);
                                                 gcv[tm] = *(const f32x4*)(GC + sc * 64 + 16 * tm + 4 * g4); }
                const bf16x4 z4 = (bf16x4){0, 0, 0, 0};
                bf16x8 BS[2];
#pragma unroll
                for (int s = 0; s < 2; ++s) BS[s] = pk8(ST[2 * s], ST[2 * s + 1]);
                f32x4 rhs = (f32x4){0.f, 0.f, 0.f, 0.f}, yy = rhs;
#pragma unroll
                for (int s = 0; s < 2; ++s) {
                    rhs = mfma16(__builtin_shufflevector(alo[s], ahi[s], 0, 1, 2, 3, 4, 5, 6, 7), BS[s], rhs);
                    yy = mfma16(__builtin_shufflevector(qlo[s], qhi[s], 0, 1, 2, 3, 4, 5, 6, 7), BS[s], yy);
                }
                rhs = mfma16(__builtin_shufflevector(l4, z4, 0, 1, 2, 3, 4, 5, 6, 7), __builtin_shufflevector(vm4, z4, 0, 1, 2, 3, 4, 5, 6, 7), rhs);
                f32x4 uu = (f32x4){0.f, 0.f, 0.f, 0.f};
                { u32x4 rbw = (u32x4){pk2(rhs[0], rhs[1]), pk2(rhs[2], rhs[3]), 0u, 0u}; const bf16x8 rb = __builtin_bit_cast(bf16x8, rbw);
                  uu = mfma16(__builtin_shufflevector(t4, z4, 0, 1, 2, 3, 4, 5, 6, 7), rb, uu); }
                const u32x2 vmw = __builtin_bit_cast(u32x2, vm4);
                const u32x4 uvw = (u32x4){pk2(uu[0], uu[1]), pk2(uu[2], uu[3]), vmw.x, vmw.y};
                const bf16x8 UV = __builtin_bit_cast(bf16x8, uvw);
                yy = mfma16(__builtin_shufflevector(m1, m2, 0, 1, 2, 3, 4, 5, 6, 7), UV, yy);
#pragma unroll
                for (int tm = 0; tm < 4; ++tm) { ST[tm] = mfma16(__builtin_shufflevector(b4[tm], c4v[tm], 0, 1, 2, 3, 4, 5, 6, 7), UV, ST[tm]); ST[tm] = ST[tm] * gcv[tm]; }
#pragma unroll
                for (int e = 0; e < 4; ++e) Y[(16 * sc + 4 * g4 + e) * FS + 16 * w + l16] = yy[e];
            }
        }
        __syncthreads();
        {
            const f32x4 y4 = *(const f32x4*)(Y + ti * FS + 4 * q), gg = *(const f32x4*)(GG + ti * FS + 4 * q);
            const float mean = red16(y4[0] + y4[1] + y4[2] + y4[3]) * (1.0f / 64.0f);
            const f32x4 dd = y4 - mean;
            const float var = red16(dd[0] * dd[0] + dd[1] * dd[1] + dd[2] * dd[2] + dd[3] * dd[3]) * (1.0f / 64.0f);
            const f32x4 lnw = *(const f32x4*)(CST + 384 + 4 * q), lnb = *(const f32x4*)(CST + 448 + 4 * q);
            const f32x4 yn = dd * __builtin_amdgcn_rsqf(var + 64e-5f) * lnw + lnb;
            const f32x4 o4 = (yn + v4 * BON[ti]) * gg;
            if (valid && st) { u32x2 o; o.x = pk2(o4[0], o4[1]); o.y = pk2(o4[2], o4[3]); *(u32x2*)(P + (rowbase + t) * LDP + PC_RR + C4) = o; }
        }
    }
}

#ifdef PROBE_CLASS
__device__ __forceinline__ void probe_scale_rows(const float* w, float* wout, float s) { for (int i = threadIdx.x; i < 1024; i += NTHR) wout[i] = w[i] * s; __syncthreads(); }
#endif
#define XB_TMO      128
#define XB_XCNT(j)  (256  + 64 * (j))
#define XB_XSUB(j)  (1280 + 64 * (j))
#define XB_XGEN(j)  (2304 + 64 * (j))
#define XB_TOP      3328
#define XB_TOPGEN   3392
#define XCD_BAR_WORDS 3456
#define XB_SPIN_CAP (1u << 18)

__device__ __forceinline__ unsigned xb_ld(unsigned* p)              { return __hip_atomic_load(p, __ATOMIC_RELAXED, __HIP_MEMORY_SCOPE_AGENT); }
__device__ __forceinline__ unsigned xb_add(unsigned* p, unsigned v) { return __hip_atomic_fetch_add(p, v, __ATOMIC_RELAXED, __HIP_MEMORY_SCOPE_AGENT); }
__device__ __forceinline__ unsigned xb_xcc_id() { return (unsigned)__builtin_amdgcn_s_getreg((3 << 11) | 20) & 0xFu; }
#define XB_SPIN(cond, bar) do { unsigned _sp = 0; while (cond) { __builtin_amdgcn_s_sleep(1); \
    if ((++_sp & 255u) == 0u) { if (xb_ld(&(bar)[XB_TMO])) break; if (_sp > XB_SPIN_CAP) { atomicAdd(&(bar)[XB_TMO], 1u); break; } } } } while (0)

struct XcdBarrier {
    unsigned* bar; unsigned x;
    volatile LAS unsigned* st;
};

__device__ __forceinline__ XcdBarrier xcd_barrier_post(unsigned* bar, volatile LAS unsigned* st) {
    XcdBarrier b; b.bar = bar; b.x = xb_xcc_id(); b.st = st;
    if (threadIdx.x == 0) (void)xb_add(&bar[XB_XCNT(b.x)], 1u);
    return b;
}
__device__ __forceinline__ void xcd_barrier_complete(unsigned* bar, unsigned x, unsigned& nloc, unsigned& nx) {
    const unsigned G = gridDim.x * gridDim.y * gridDim.z;
    unsigned sum, cnt, mine, sp = 0u;
    for (;;) {
        sum = 0u; cnt = 0u; mine = 0u;
#pragma unroll
        for (unsigned j = 0; j < 16; ++j) { const unsigned c = xb_ld(&bar[XB_XCNT(j)]); sum += c; cnt += (c > 0u) ? 1u : 0u; mine = (j == x) ? c : mine; }
        if (sum == G) break;
        __builtin_amdgcn_s_sleep(1);
        if ((++sp & 255u) == 0u) { if (xb_ld(&bar[XB_TMO])) break; if (sp > XB_SPIN_CAP) { atomicAdd(&bar[XB_TMO], 1u); break; } }
    }
    nloc = mine > 0u ? mine : 1u; nx = cnt > 0u ? cnt : 1u;
}

__device__ __forceinline__ void xcd_barrier(const XcdBarrier& b) {
    asm volatile("s_waitcnt vmcnt(0)" ::: "memory");
    __syncthreads();
    if (threadIdx.x == 0) {
        unsigned* bar = b.bar;
        __builtin_amdgcn_s_waitcnt(0);
        unsigned nloc = b.st[0], nx = b.st[1];
        if (nloc == 0u) { xcd_barrier_complete(bar, b.x, nloc, nx); b.st[0] = nloc; b.st[1] = nx; }
        const unsigned old = xb_add(&bar[XB_XSUB(b.x)], 1u);
        const unsigned gen = old / nloc;
        if (old + 1u == (gen + 1u) * nloc) {
            __builtin_amdgcn_fence(__ATOMIC_RELEASE, "agent");
            asm volatile("s_waitcnt vmcnt(0)" ::: "memory");
            const unsigned og = xb_add(&bar[XB_TOP], 1u);
            const unsigned tg = og / nx;
            if (og + 1u == (tg + 1u) * nx) xb_add(&bar[XB_TOPGEN], 1u);
            else XB_SPIN(xb_ld(&bar[XB_TOPGEN]) == tg, bar);
            __builtin_amdgcn_fence(__ATOMIC_ACQUIRE, "agent");
            xb_add(&bar[XB_XGEN(b.x)], 1u);
            asm volatile("s_waitcnt vmcnt(0)" ::: "memory");
        } else {
            XB_SPIN(xb_ld(&bar[XB_XGEN(b.x)]) == gen, bar);
            __builtin_amdgcn_fence(__ATOMIC_ACQUIRE, "agent");
            asm volatile("s_waitcnt vmcnt(0)" ::: "memory");
        }
    }
    __syncthreads();
}

__global__ void __launch_bounds__(NTHR) mega(Args args) {
    extern __shared__ __attribute__((aligned(16))) unsigned char lds[];
    cg::grid_group grid = cg::this_grid();
    LAS unsigned char* ldsl = (LAS unsigned char*)lds;
    unsigned char* ws = args.ws;
    float* Z = (float*)(ws + WS_Z); bf16_t* P = (bf16_t*)(ws + WS_P); unsigned char* wb = ws + WS_WB;
    bf16_t* H = (bf16_t*)((unsigned char*)args.out + DO_H); bf16_t* VF = (bf16_t*)((unsigned char*)args.out + DO_VF);
    const int G = gridDim.x, c = blockIdx.x;
    unsigned* bar_words = (unsigned*)(ws + 4096);
    volatile LAS unsigned* bar_st = (volatile LAS unsigned*)(ldsl + LDS_BYTES - 64);
    if (c == 0) for (int i = threadIdx.x; i < XCD_BAR_WORDS; i += NTHR) bar_words[i] = 0u;
    if (threadIdx.x == 0) { bar_st[0] = 0u; bar_st[1] = 0u; }
    __syncthreads();
#ifdef PROBE_CLASS
    unsigned long long tacc = 0, tprev = __builtin_amdgcn_s_memrealtime();
#define TICK(k) do { const unsigned long long tn = __builtin_amdgcn_s_memrealtime(); if ((PROBE_CLASS >> (k)) & 1) tacc += tn - tprev; tprev = tn; } while (0)
#else
#define TICK(k) do {} while (0)
#endif

    convert_weights(args, 0, wb, (float*)lds);
    norm_rows(0, args.in[0], args.in[1], Z, args.in[2], H, nullptr);
    grid.sync(); TICK(0);
    const XcdBarrier xb = xcd_barrier_post(bar_words, bar_st);
#pragma unroll 1
    for (int l = 0; l < 2; ++l) {
        if (l == 1) { convert_weights(args, 1, wb, (float*)lds); norm_rows(1, nullptr, nullptr, Z, args.in[2] + 1024, H, nullptr); xcd_barrier(xb); TICK(0); }
        {
            pg::GemmPlain g{H, (const bf16_t*)(wb + WB_WIN), 1024, 1024, 1024}; pg::Order2D S; S.init(129, 22, G, c, 1, 1); pg::EpiP E{P};
#ifndef NO_G1
            pg::gemm_phase(ldsl, g, S, E);
            { pg::Order2D T; T.init(129, 22, G, c, 1, 2); pg::gemm_phase<true>(ldsl, g, T, E); }
#endif
#if defined(REP_MASK) && (REP_MASK & 1)
            pg::gemm_phase(ldsl, g, S, E);
#endif
        }
        xcd_barrier(xb); TICK(1);
        for (int it = c; it < 256; it += G) {
#ifndef NO_RW
            if (it < 128) rwkv_unit(lds, P, VF, it >> 3, it & 7, l, args);
#endif
#ifndef NO_GLA
            if (it >= 128 && it < 192) gla_unit<64, false>(lds, P, (it - 128) >> 2, (it - 128) & 3, l, args);
#endif
#ifndef NO_HG
            if (it >= 192) gla_unit<128, true>(lds, P, (it - 192) >> 2, (it - 192) & 3, l, args);
#endif
            __syncthreads();
        }
#if defined(REP_MASK) && (REP_MASK & 14)
        { const bool never = (args.ws == nullptr);
        for (int it = c; it < 256; it += G) {
#if REP_MASK & 2
            if (it < 128) rwkv_unit(lds, P, VF, it >> 3, it & 7, l, args, never);
#endif
#if REP_MASK & 4
            if (it >= 128 && it < 192) gla_unit<64, false>(lds, P, (it - 128) >> 2, (it - 128) & 3, l, args, never);
#endif
#if REP_MASK & 8
            if (it >= 192) gla_unit<128, true>(lds, P, (it - 192) >> 2, (it - 192) & 3, l, args, never);
#endif
            __syncthreads();
        } }
#endif
        xcd_barrier(xb); TICK(2);
        {
            pg::GemmPlain g{H, (const bf16_t*)(wb + WB_WG), 1024, 1024, 1024}; pg::Order2D S; S.init(129, 12, G, c, 1, 1); pg::EpiGate E{P};
#ifndef NO_M1
            pg::gemm_phase(ldsl, g, S, E);
            { pg::Order2D T; T.init(129, 12, G, c, 1, 2); pg::gemm_phase<true>(ldsl, g, T, E); }
#endif
#if defined(REP_MASK) && (REP_MASK & 128)
            pg::gemm_phase(ldsl, g, S, E);
#endif
        }
        xcd_barrier(xb); TICK(3);
        {
            pg::GemmMerge g{P, (const bf16_t*)(wb + WB_WO), LDP, 512, 512}; pg::Order2D S; S.init(129, 4, G, c, 3, 1); pg::EpiMerge E{P, H};
#ifndef NO_M2
            pg::gemm_phase(ldsl, g, S, E);
            { pg::Order2D T; T.init(129, 4, G, c, 3, 2); pg::gemm_phase<true>(ldsl, g, T, E); }
#endif
#if defined(REP_MASK) && (REP_MASK & 256)
            pg::gemm_phase(ldsl, g, S, E);
#endif
        }
        xcd_barrier(xb); TICK(4);
        {
            pg::GemmSplit g{H, (const bf16_t*)(wb + WB_WOUT), 1024, 1024, 1024, 128}; pg::OrderSplit S; S.init(129, 4, G, c, 8); pg::EpiResid E{Z};
#ifndef NO_O
            pg::gemm_phase(ldsl, g, S, E);
#endif
        }
        xcd_barrier(xb); TICK(5);
        norm_rows(1, nullptr, nullptr, Z, args.in[28] + l * 1024, H, nullptr);
        xcd_barrier(xb); TICK(6);
        {
            pg::GemmUp g{H, (const bf16_t*)(wb + WB_WUP), 1024, 1024, 1024}; pg::Order2D S; S.init(131, 22, G, c);
            pg::EpiFFN E{P, args.in[30] + (size_t)l * 3 * 5632, args.in[31] + (size_t)l * 5632};
#ifndef NO_U
            pg::gemm_phase(ldsl, g, S, E);
#endif
#if defined(REP_MASK) && (REP_MASK & 16)
            pg::gemm_phase(ldsl, g, S, E);
#endif
        }
        xcd_barrier(xb); TICK(7);
        {
            pg::GemmSplit g{P, (const bf16_t*)(wb + WB_WDN), DFF, DFF, DFF, 256}; pg::OrderSplit S; S.init(129, 4, G, c, 11); pg::EpiResid E{Z};
#ifndef NO_D
            pg::gemm_phase(ldsl, g, S, E);
#endif
        }
        xcd_barrier(xb); TICK(8);
    }
#ifdef PROBE_CLASS
    if (c == 0 && threadIdx.x == 0) *(volatile float*)(ws + 1024) = 1.0f + (float)tacc * (1.0f / 5000000.0f);
    __threadfence(); xcd_barrier(xb);
    probe_scale_rows(args.in[33], (float*)(ws + 2048), *(volatile float*)(ws + 1024));
    norm_rows(2, nullptr, nullptr, Z, (const float*)(ws + 2048), nullptr, args.out);
#else
    norm_rows(2, nullptr, nullptr, Z, args.in[33], nullptr, args.out);
#endif
#ifdef EXTRA_SYNCS
    for (int i = 0; i < EXTRA_SYNCS; ++i) xcd_barrier(xb);
#endif
}

extern "C" void kernel_launch(void* const* d_in, const int* in_sizes, int n_in, void* d_out, int out_size, void* d_ws, size_t ws_size, hipStream_t stream) {
    static int grid = 0;
    if (grid == 0) {
        int dev = 0, cus = 0, per_cu = 0;
        hipGetDevice(&dev);
        hipDeviceGetAttribute(&cus, hipDeviceAttributeMultiprocessorCount, dev);
        if (hipFuncSetAttribute((const void*)mega, hipFuncAttributeMaxDynamicSharedMemorySize, LDS_BYTES) != hipSuccess) fprintf(stderr, "kernel_launch: hipFuncSetAttribute failed\n");
        if (hipOccupancyMaxActiveBlocksPerMultiprocessor(&per_cu, (const void*)mega, NTHR, LDS_BYTES) != hipSuccess || per_cu < 1) { fprintf(stderr, "kernel_launch: occupancy query gave %d\n", per_cu); per_cu = 1; }
        (void)hipGetLastError();
        grid = cus * per_cu;
        if (n_in != 34 || ws_size < WS_WB + WB_END) fprintf(stderr, "kernel_launch: unexpected n_in %d / ws_size %zu\n", n_in, ws_size);
    }
    Args a{};
    for (int i = 0; i < 34; ++i) a.in[i] = (const float*)d_in[i];
    a.out = (float*)d_out; a.ws = (unsigned char*)d_ws;
    void* kargs[] = {&a};
    hipError_t e = hipLaunchCooperativeKernel((const void*)mega, dim3(grid), dim3(NTHR), kargs, LDS_BYTES, stream);
    if (e != hipSuccess) fprintf(stderr, "kernel_launch: cooperative launch failed: %s (grid %d)\n", hipGetErrorString(e), grid);
}
```

```cpp
#include <hip/hip_runtime.h>
#include <hip/hip_cooperative_groups.h>
#include <cstdio>
#include <cstdint>
namespace cg = cooperative_groups;

#define LAS __attribute__((address_space(3)))
typedef unsigned short bf16_t;
typedef short bf16x8 __attribute__((ext_vector_type(8)));
typedef short bf16x4 __attribute__((ext_vector_type(4)));
typedef float f32x4 __attribute__((ext_vector_type(4)));
typedef unsigned u32x4 __attribute__((ext_vector_type(4)));
typedef unsigned u32x2 __attribute__((ext_vector_type(2)));

constexpr int NB = 16, TS = 2064, MROWS = NB * TS  , DM = 1024, LDP = 5424, DFF = 2816;
constexpr int NTHR = 512;
constexpr int PC_GQ = 0, PC_GK = 256, PC_GV = 512, PC_GG = 1024, PC_HQ = 1536, PC_HF = 2048, PC_HI = 2560, PC_HG = 3072,
              PC_RR = 3584, PC_RK = 4096, PC_RV = 4608, PC_RW = 5120, PC_RA = 5184, PC_RG = 5248, PC_RVR = 5376, PC_GGK = 5408;
constexpr size_t WS_Z = 65536;
constexpr size_t WS_P = WS_Z + (size_t)MROWS * DM * 4;
constexpr size_t WS_WB = WS_P + (size_t)MROWS * LDP * 2;
constexpr size_t WB_WIN = 0, WB_WG = 11534336, WB_WO = 17825792, WB_WOUT = 20971520, WB_WUP = 23068672, WB_WDN = 34603008, WB_END = 40370176;
static_assert(WS_WB + WB_END <= 536870912ull, "ws map");
constexpr size_t DO_H = 4096, DO_VF = 68157440;
constexpr int LDS_BYTES = 147456;
constexpr int LDS_XCH = 131072;

struct Args { const float* in[34]; float* out; unsigned char* ws; };

typedef __bf16 bf16x2_t __attribute__((ext_vector_type(2)));
typedef float f32x2_t __attribute__((ext_vector_type(2)));
__device__ __forceinline__ unsigned pk2(float lo, float hi) { const f32x2_t v = {lo, hi}; const bf16x2_t b = __builtin_convertvector(v, bf16x2_t); return __builtin_bit_cast(unsigned, b); }
__device__ __forceinline__ unsigned f2bf(float f) { return pk2(f, f) & 0xffffu; }
__device__ __forceinline__ bf16x8 pk8(f32x4 a, f32x4 b) { u32x4 w; w.x = pk2(a[0], a[1]); w.y = pk2(a[2], a[3]); w.z = pk2(b[0], b[1]); w.w = pk2(b[2], b[3]); return __builtin_bit_cast(bf16x8, w); }
__device__ __forceinline__ float bf2f(unsigned short h) { return __builtin_bit_cast(float, (unsigned)h << 16); }
__device__ __forceinline__ float bflo(unsigned w) { return __builtin_bit_cast(float, w << 16); }
__device__ __forceinline__ float bfhi(unsigned w) { return __builtin_bit_cast(float, w & 0xffff0000u); }
__device__ __forceinline__ float sigmoidf_(float x) { return __builtin_amdgcn_rcpf(1.0f + __expf(-x)); }
__device__ __forceinline__ float softplusf_(float x) { return fmaxf(x, 0.f) + __logf(1.0f + __expf(-fabsf(x))); }
__device__ __forceinline__ float tanhf_(float x) { float e = __expf(2.0f * x); return 1.0f - 2.0f * __builtin_amdgcn_rcpf(e + 1.0f); }
template <int CTRL> __device__ __forceinline__ float dppf(float x) {
    return __builtin_bit_cast(float, __builtin_amdgcn_update_dpp(0, __builtin_bit_cast(int, x), CTRL, 0xf, 0xf, true));
}
__device__ __forceinline__ float red8(float x) { x += dppf<0xB1>(x); x += dppf<0x4E>(x); x += dppf<0x141>(x); return x; }
__device__ __forceinline__ float red16(float x) { x = red8(x); x += dppf<0x140>(x); return x; }
__device__ __forceinline__ float wave_sum(float v) {
#pragma unroll
    for (int o = 32; o > 0; o >>= 1) v += __shfl_xor(v, o, 64);
    return v;
}
#define LDS_WAIT() asm volatile("s_waitcnt lgkmcnt(0)" ::: "memory")
#define WG_BAR() do { asm volatile("s_waitcnt lgkmcnt(0)" ::: "memory"); __builtin_amdgcn_s_barrier(); asm volatile("" ::: "memory"); } while (0)

namespace pg {
constexpr int BM = 256, BK = 64, HALF = 128, HTB = HALF * BK * 2, STAGE_BYTES = 8 * HTB, NXCD = 8, WGM = 8;
__host__ __device__ __forceinline__ int lds_byte(int r, int c) { const int st = (r >> 4) * 2 + (c >> 5), rr = r & 15, cc = c & 31, ob = rr * 64 + cc * 2; return st * 1024 + (ob ^ (((ob >> 9) & 1) << 5)); }
__host__ __device__ __forceinline__ void stage_rc(int b, int& R, int& C) { const int st = b / 1024, sb = b % 1024, swz = sb ^ (((sb >> 9) & 1) << 5); R = (st >> 1) * 16 + swz / 64; C = (st & 1) * 32 + (swz % 64) / 2; }
__host__ __device__ __forceinline__ int perm32(int rho) { const int n = rho >> 4, i = rho & 15; return 8 * (i >> 2) + 4 * n + (i & 3); }

struct Unit { int pm, pn, aux, half; };

struct Order2D {
    int nM, nN, nwg, G, c, rep, mode;
    __device__ void init(int nM_, int nN_, int G_, int c_, int rep_ = 1, int mode_ = 0) { nM = nM_; nN = nN_; nwg = nM * nN; G = G_; c = c_; rep = rep_; mode = mode_; }
    __device__ bool next(int i, Unit& u) const {
        const int ti = i / rep; u.aux = i - ti * rep; u.half = -1;
        long L = (long)ti * G + c;
        if (mode == 1) { if (ti >= nwg / G) return false; }
        if (mode == 2) { const int full = nwg / G, rem = nwg - full * G; if (ti > 0 || c >= 2 * rem) return false; L = (long)full * G + (c >> 1); u.half = c & 1; }
        if (L >= nwg) return false;
        int wgid = (int)L; { const int q = nwg / NXCD, r = nwg % NXCD, xcd = wgid % NXCD, off = wgid / NXCD; wgid = (xcd < r ? xcd * (q + 1) : r * (q + 1) + (xcd - r) * q) + off; }
        const int nig = WGM * nN, gid = wgid / nig, fm = gid * WGM, gsz = (nM - fm) < WGM ? (nM - fm) : WGM;
        u.pm = fm + ((wgid % nig) % gsz); u.pn = (wgid % nig) / gsz; return true;
    }
};

struct OrderSplit {
    Order2D base; int full, S;
    __device__ void init(int nM_, int nN_, int G_, int c_, int S_) { base.init(nM_, nN_, G_, c_); full = base.nwg / G_; S = S_; }
    __device__ bool next(int i, Unit& u) const {
        if (i < full) { const bool ok = base.next(i, u); u.aux = -1; return ok; }
        if (i > full) return false;
        const int rem = base.nwg - full * base.G, j = base.c; if (j >= rem * S) return false;
        Order2D t = base; t.c = j / S;
        const bool ok = t.next(full, u); u.aux = j - (j / S) * S; return ok;
    }
};
template <bool HN = false, class Epi, class G, class Sched>
__device__ __forceinline__ void gemm_phase(LAS unsigned char* lds, const G g, const Sched& S, const Epi& E) {
    int tid; asm volatile("v_mov_b32 %0, %1" : "=v"(tid) : "v"((int)threadIdx.x));
    const int wid = __builtin_amdgcn_readfirstlane(tid >> 6), lane = tid & 63, wr = wid >> 2, wc = wid & 3, fr = lane & 15, fq = lane >> 4;
    unsigned voffA[2], voffB[2];
#pragma unroll
    for (int i = 0; i < 2; ++i) { int R, C; stage_rc(tid * 16 + i * 8192, R, C); const int Rb = Epi::PERM ? ((R & ~31) + perm32(R & 31)) : R;
        voffA[i] = (unsigned)(R * g.lda + C) * 2u; voffB[i] = (unsigned)(Rb * g.ldb + C) * 2u; }
    const size_t kstep = (size_t)(BK * 2);
    const size_t hstepA = (size_t)HALF * g.lda * 2, hstepB = (size_t)HALF * g.ldb * 2;
    const unsigned ldsw = (unsigned)wid * 1024u;
    const int aoff = lds_byte(wr * 64 + fr, fq * 8), boff = lds_byte(wc * 32 + fr, fq * 8);
#define PG_SA(b, h) (((b) * 2 + (h)) * HTB)
#define PG_SB(b, h) ((4 + (b) * 2 + (h)) * HTB)
#define PG_STAGE(bufoff, gbase, voff) do { _Pragma("unroll") for (int _i = 0; _i < 2; ++_i) \
        __builtin_amdgcn_global_load_lds((const unsigned*)((const char*)(gbase) + (voff)[_i]), (LAS unsigned*)(lds + (bufoff) + ldsw + _i * 8192), 16, 0, 0); } while (0)
#define PG_LDA(dst, b, h) do { _Pragma("unroll") for (int m = 0; m < 4; ++m) _Pragma("unroll") for (int k = 0; k < 2; ++k) dst[m][k] = *(const LAS bf16x8*)(lds + PG_SA(b, h) + aoff + m * 2048 + k * 1024); } while (0)
#define PG_LDB(dst, b, h) do { _Pragma("unroll") for (int n = 0; n < 2; ++n) _Pragma("unroll") for (int k = 0; k < 2; ++k) dst[n][k] = *(const LAS bf16x8*)(lds + PG_SB(b, h) + boff + n * 2048 + k * 1024); } while (0)
#define PG_MMA(ai, bj, At, Bt) do { __builtin_amdgcn_s_setprio(1); _Pragma("unroll") for (int m = 0; m < 4; ++m) _Pragma("unroll") for (int n = 0; n < 2; ++n) _Pragma("unroll") for (int k = 0; k < 2; ++k) \
        acc[ai][bj][m][n] = __builtin_amdgcn_mfma_f32_16x16x32_bf16(Bt[n][k], At[m][k], acc[ai][bj][m][n], 0, 0, 0); __builtin_amdgcn_s_setprio(0); } while (0)
#define PG_WAIT_V(n) asm volatile("s_waitcnt vmcnt(" #n ")" ::: "memory")
#define PG_WAIT_L(n) asm volatile("s_waitcnt lgkmcnt(" #n ")" ::: "memory")
#define PG_BAR __builtin_amdgcn_s_barrier()
#define PG_SCHED __builtin_amdgcn_sched_barrier(0)
    Unit cur, nxt; int ui = 0;
    if (!S.next(0, cur)) return;
    f32x4 acc[2][2][4][2];
#pragma unroll
    for (int a = 0; a < 2; ++a)
#pragma unroll
        for (int b = 0; b < 2; ++b)
#pragma unroll
            for (int m = 0; m < 4; ++m)
#pragma unroll
                for (int n = 0; n < 2; ++n) acc[a][b][m][n] = (f32x4){0.f, 0.f, 0.f, 0.f};
    bf16x8 At[4][2], B0[2][2], B1[2][2];
    const char* cA = g.a(cur); const char* cB = g.b(cur);
    PG_STAGE(PG_SB(0, 0), cB, voffB); PG_STAGE(PG_SB(0, 1), cB + hstepB, voffB); PG_STAGE(PG_SA(0, 0), cA, voffA); PG_STAGE(PG_SA(0, 1), cA + hstepA, voffA);
    if (wr == 1) PG_BAR;
    PG_WAIT_V(2); PG_BAR;
    PG_STAGE(PG_SB(1, 0), cB + kstep, voffB); PG_STAGE(PG_SA(1, 0), cA + kstep, voffA); PG_STAGE(PG_SB(1, 1), cB + hstepB + kstep, voffB);
    PG_WAIT_V(6); PG_BAR;
    for (;;) {
        const bool has_next = S.next(ui + 1, nxt);
        const char* nA = has_next ? g.a(nxt) : cA; const char* nB = has_next ? g.b(nxt) : cB;
        const int nt = g.nt(cur);
        for (int t = 0; t < nt; t += 2) {
            const bool last = (t == nt - 2);
            const char* a1 = cA + (size_t)(t + 1) * kstep;
            const char* a2 = last ? nA : cA + (size_t)(t + 2) * kstep; const char* b2 = last ? nB : cB + (size_t)(t + 2) * kstep;
            const char* a3 = a2 + kstep; const char* b3 = b2 + kstep;
            PG_LDB(B0, 0, 0); PG_LDB(B1, 0, 1); PG_SCHED; PG_LDA(At, 0, 0); PG_STAGE(PG_SA(1, 1), a1 + hstepA, voffA);
            PG_WAIT_V(8); PG_WAIT_L(0); PG_BAR; PG_MMA(0, 0, At, B0); if constexpr (!HN) PG_MMA(0, 1, At, B1); PG_BAR; PG_SCHED;
            PG_LDA(At, 0, 1); PG_STAGE(PG_SB(0, 0), b2, voffB); PG_STAGE(PG_SB(0, 1), b2 + hstepB, voffB); PG_STAGE(PG_SA(0, 0), a2, voffA);
            PG_WAIT_V(8); PG_WAIT_L(0); PG_BAR; PG_MMA(1, 0, At, B0); if constexpr (!HN) PG_MMA(1, 1, At, B1); PG_BAR; PG_SCHED;
            PG_LDB(B0, 1, 0); PG_LDB(B1, 1, 1); PG_SCHED; PG_LDA(At, 1, 0); PG_STAGE(PG_SA(0, 1), a2 + hstepA, voffA);
            PG_WAIT_V(8); PG_WAIT_L(0); PG_BAR; PG_MMA(0, 0, At, B0); if constexpr (!HN) PG_MMA(0, 1, At, B1); PG_BAR; PG_SCHED;
            PG_LDA(At, 1, 1); PG_STAGE(PG_SB(1, 0), b3, voffB); PG_STAGE(PG_SB(1, 1), b3 + hstepB, voffB); PG_STAGE(PG_SA(1, 0), a3, voffA);
            PG_WAIT_V(8); PG_WAIT_L(0); PG_BAR; PG_MMA(1, 0, At, B0); if constexpr (!HN) PG_MMA(1, 1, At, B1); PG_BAR; PG_SCHED;
        }
        if (wr == 0) PG_BAR;
        { int te; asm volatile("v_mov_b32 %0, %1" : "=v"(te) : "v"((int)threadIdx.x)); const int le = te & 63; E(acc, cur, wr, wc, le & 15, le >> 4, lds); }
        if (!has_next) break;
#pragma unroll
        for (int a = 0; a < 2; ++a)
#pragma unroll
            for (int b = 0; b < 2; ++b)
#pragma unroll
                for (int m = 0; m < 4; ++m)
#pragma unroll
                    for (int n = 0; n < 2; ++n) acc[a][b][m][n] = (f32x4){0.f, 0.f, 0.f, 0.f};
        cur = nxt; cA = nA; cB = nB; ++ui;
        if (wr == 1) PG_BAR;
    }
    PG_WAIT_V(0);
    PG_BAR;
#undef PG_SA
#undef PG_SB
#undef PG_STAGE
#undef PG_LDA
#undef PG_LDB
#undef PG_MMA
#undef PG_WAIT_V
#undef PG_WAIT_L
#undef PG_BAR
#undef PG_SCHED
}

struct GemmPlain { const bf16_t* A; const bf16_t* Bt; int lda, ldb, K;
    __device__ __forceinline__ const char* a(const Unit& u) const { return (const char*)(A + (size_t)u.pm * 256 * lda); }
    __device__ __forceinline__ const char* b(const Unit& u) const { return (const char*)(Bt + ((size_t)u.pn * 256 + (u.half > 0 ? 128 : 0)) * ldb); }
    __device__ __forceinline__ int nt(const Unit&) const { return K / BK; } };
struct GemmSplit { const bf16_t* A; const bf16_t* Bt; int lda, ldb, K, KS;
    __device__ __forceinline__ const char* a(const Unit& u) const { return (const char*)(A + (size_t)u.pm * 256 * lda + (u.aux > 0 ? u.aux * KS : 0)); }
    __device__ __forceinline__ const char* b(const Unit& u) const { return (const char*)(Bt + (size_t)u.pn * 256 * ldb + (u.aux > 0 ? u.aux * KS : 0)); }
    __device__ __forceinline__ int nt(const Unit& u) const { return (u.aux >= 0 ? KS : K) / BK; } };
struct GemmMerge { const bf16_t* P; const bf16_t* Wo; int lda, ldb, K;
    __device__ __forceinline__ const char* a(const Unit& u) const { const int yc = u.aux == 0 ? PC_GG : (u.aux == 1 ? PC_RR : PC_HG); return (const char*)(P + (size_t)u.pm * 256 * LDP + yc); }
    __device__ __forceinline__ const char* b(const Unit& u) const { return (const char*)(Wo + (size_t)u.aux * 1024 * 512 + ((size_t)u.pn * 256 + (u.half > 0 ? 128 : 0)) * 512); }
    __device__ __forceinline__ int nt(const Unit&) const { return K / BK; } };
struct GemmUp { const bf16_t* H; const bf16_t* Bt; int lda, ldb, K;
    __device__ __forceinline__ const char* a(const Unit& u) const { return (const char*)(H + ((long)u.pm * 254 - 2) * 1024); }
    __device__ __forceinline__ const char* b(const Unit& u) const { return (const char*)(Bt + (size_t)u.pn * 256 * 1024); }
    __device__ __forceinline__ int nt(const Unit&) const { return K / BK; } };

__device__ __forceinline__ int gmap(int j) { return j < 4 ? 256 * j : (j < 10 ? 1536 + 256 * (j - 4) : 4096 + 256 * (j - 10)); }

struct EpiP {
    static constexpr bool PERM = true; bf16_t* P;
    __device__ __forceinline__ void operator()(const f32x4 (&acc)[2][2][4][2], const Unit& u, int wr, int wc, int fr, int fq, LAS unsigned char*) const {
        const int row0 = u.pm * 256 + wr * 64 + fr, col0 = u.pn * 256 + wc * 32 + 8 * fq + (u.half > 0 ? 128 : 0); const int nbj = u.half >= 0 ? 1 : 2;
#pragma unroll
        for (int ai = 0; ai < 2; ++ai)
#pragma unroll
            for (int m = 0; m < 4; ++m) { bf16_t* rowp = P + (size_t)(row0 + ai * 128 + m * 16) * LDP;
#pragma unroll
                for (int bj = 0; bj < 2; ++bj) { const int col = col0 + bj * 128; if (bj < nbj && col < LDP) { const f32x4 v0 = acc[ai][bj][m][0], v1 = acc[ai][bj][m][1];
                    u32x4 w; w.x = pk2(v0[0], v0[1]); w.y = pk2(v0[2], v0[3]); w.z = pk2(v1[0], v1[1]); w.w = pk2(v1[2], v1[3]); *(u32x4*)(rowp + col) = w; } } }
    }
};
struct EpiGate {
    static constexpr bool PERM = true; bf16_t* P;
    __device__ __forceinline__ void operator()(const f32x4 (&acc)[2][2][4][2], const Unit& u, int wr, int wc, int fr, int fq, LAS unsigned char*) const {
        const int row0 = u.pm * 256 + wr * 64 + fr, col0 = gmap(u.pn) + wc * 32 + 8 * fq + (u.half > 0 ? 128 : 0); const int nbj = u.half >= 0 ? 1 : 2;
#pragma unroll
        for (int ai = 0; ai < 2; ++ai)
#pragma unroll
            for (int m = 0; m < 4; ++m) { bf16_t* rowp = P + (size_t)(row0 + ai * 128 + m * 16) * LDP + col0;
#pragma unroll
                for (int bj = 0; bj < 2; ++bj) { if (bj >= nbj) continue; const f32x4 v0 = acc[ai][bj][m][0], v1 = acc[ai][bj][m][1];
                    u32x4 w; w.x = pk2(sigmoidf_(v0[0]), sigmoidf_(v0[1])); w.y = pk2(sigmoidf_(v0[2]), sigmoidf_(v0[3]));
                    w.z = pk2(sigmoidf_(v1[0]), sigmoidf_(v1[1])); w.w = pk2(sigmoidf_(v1[2]), sigmoidf_(v1[3])); *(u32x4*)(rowp + bj * 128) = w; } }
    }
};
struct EpiMerge {
    static constexpr bool PERM = true; const bf16_t* __restrict__ P; bf16_t* __restrict__ Mg;
    __device__ __forceinline__ void operator()(const f32x4 (&acc)[2][2][4][2], const Unit& u, int wr, int wc, int fr, int fq, LAS unsigned char*) const {
        const int row0 = u.pm * 256 + wr * 64 + fr, cin = wc * 32 + 8 * fq + (u.half > 0 ? 128 : 0), br = u.aux; const int nbj = u.half >= 0 ? 1 : 2;
        const int gcol = gmap(4 * br + u.pn) + cin, mcol = u.pn * 256 + cin;
#pragma unroll
        for (int ai = 0; ai < 2; ++ai) {
            u32x4 gw[4][2], pw[4][2];
#pragma unroll
            for (int m = 0; m < 4; ++m)
#pragma unroll
                for (int bj = 0; bj < 2; ++bj) { const size_t row = (size_t)(row0 + ai * 128 + m * 16);
                    gw[m][bj] = (u32x4){0u, 0u, 0u, 0u}; pw[m][bj] = (u32x4){0u, 0u, 0u, 0u};
                    if (bj < nbj) { gw[m][bj] = *(const u32x4*)(P + row * LDP + gcol + bj * 128); if (br > 0) pw[m][bj] = *(const u32x4*)(Mg + row * 1024 + mcol + bj * 128); } }
#pragma unroll
            for (int m = 0; m < 4; ++m)
#pragma unroll
                for (int bj = 0; bj < 2; ++bj) { if (bj >= nbj) continue; const size_t row = (size_t)(row0 + ai * 128 + m * 16);
                    const f32x4 v0 = acc[ai][bj][m][0], v1 = acc[ai][bj][m][1]; const u32x4 g = gw[m][bj], p = pw[m][bj];
                    float r[8] = { bflo(g.x) * v0[0], bfhi(g.x) * v0[1], bflo(g.y) * v0[2], bfhi(g.y) * v0[3], bflo(g.z) * v1[0], bfhi(g.z) * v1[1], bflo(g.w) * v1[2], bfhi(g.w) * v1[3] };
                    r[0] += bflo(p.x); r[1] += bfhi(p.x); r[2] += bflo(p.y); r[3] += bfhi(p.y); r[4] += bflo(p.z); r[5] += bfhi(p.z); r[6] += bflo(p.w); r[7] += bfhi(p.w);
                    u32x4 w; w.x = pk2(r[0], r[1]); w.y = pk2(r[2], r[3]); w.z = pk2(r[4], r[5]); w.w = pk2(r[6], r[7]); *(u32x4*)(Mg + row * 1024 + mcol + bj * 128) = w; }
        }
    }
};
struct EpiResid {
    static constexpr bool PERM = false; float* Z;
    __device__ __forceinline__ void operator()(const f32x4 (&acc)[2][2][4][2], const Unit& u, int wr, int wc, int fr, int fq, LAS unsigned char*) const {
        const int row0 = u.pm * 256 + wr * 64 + fr, col0 = u.pn * 256 + wc * 32 + 4 * fq;
        if (u.aux < 0) {
#pragma unroll
            for (int ai = 0; ai < 2; ++ai) {
                f32x4 zv[4][2][2];
#pragma unroll
                for (int m = 0; m < 4; ++m)
#pragma unroll
                    for (int bj = 0; bj < 2; ++bj)
#pragma unroll
                        for (int n = 0; n < 2; ++n) zv[m][bj][n] = *(const f32x4*)(Z + (size_t)(row0 + ai * 128 + m * 16) * 1024 + col0 + bj * 128 + n * 16);
#pragma unroll
                for (int m = 0; m < 4; ++m)
#pragma unroll
                    for (int bj = 0; bj < 2; ++bj)
#pragma unroll
                        for (int n = 0; n < 2; ++n) *(f32x4*)(Z + (size_t)(row0 + ai * 128 + m * 16) * 1024 + col0 + bj * 128 + n * 16) = zv[m][bj][n] + acc[ai][bj][m][n];
            }
        } else {
#pragma unroll
            for (int ai = 0; ai < 2; ++ai)
#pragma unroll
                for (int m = 0; m < 4; ++m) { float* rowp = Z + (size_t)(row0 + ai * 128 + m * 16) * 1024 + col0;
#pragma unroll
                    for (int bj = 0; bj < 2; ++bj)
#pragma unroll
                        for (int n = 0; n < 2; ++n) { float* p = rowp + bj * 128 + n * 16; const f32x4 v = acc[ai][bj][m][n];
                            unsafeAtomicAdd(p, v[0]); unsafeAtomicAdd(p + 1, v[1]); unsafeAtomicAdd(p + 2, v[2]); unsafeAtomicAdd(p + 3, v[3]); } }
        }
    }
};
struct EpiFFN {
    static constexpr bool PERM = true; bf16_t* Act; const float* cw; const float* cb;
    __device__ __forceinline__ void operator()(f32x4 (&acc)[2][2][4][2], const Unit& u, int wr, int wc, int fr, int fq, LAS unsigned char* lds) const {
        LAS float* xch = (LAS float*)(lds + LDS_XCH);
        const int ccol = wc * 32 + 8 * fq;
        if (fr >= 14) {
#pragma unroll
            for (int ai = 0; ai < 2; ++ai)
#pragma unroll
                for (int bj = 0; bj < 2; ++bj)
#pragma unroll
                    for (int n = 0; n < 2; ++n) *(LAS f32x4*)(xch + ((2 * ai + wr) * 2 + (fr - 14)) * 256 + bj * 128 + ccol + 4 * n) = acc[ai][bj][3][n];
        }
        WG_BAR();
        const int ffbase = u.pn * 128 + ccol;
        const int Rbase = u.pm * 254 - 2 + wr * 64 + fr;
        unsigned mk0 = 0u, mk1 = 0u;
#pragma unroll
        for (int ai = 0; ai < 2; ++ai)
#pragma unroll
            for (int m = 0; m < 4; ++m) { const int tm = (Rbase + ai * 128 + m * 16 + TS) % TS; mk0 |= (tm == 0 ? 1u : 0u) << (4 * ai + m); mk1 |= (tm < 2 ? 1u : 0u) << (4 * ai + m); }
        const bool f0 = fr == 0, f1 = fr == 1;
#pragma unroll
        for (int n = 0; n < 2; ++n) {
            f32x4 cwv[2][4];
#pragma unroll
            for (int bj = 0; bj < 2; ++bj) { const int cc4 = bj * DFF + ffbase + 4 * n;
                cwv[bj][0] = *(const f32x4*)(cw + cc4); cwv[bj][1] = *(const f32x4*)(cw + 2 * DFF + cc4); cwv[bj][2] = *(const f32x4*)(cw + 4 * DFF + cc4); cwv[bj][3] = *(const f32x4*)(cb + cc4); }
#pragma unroll
            for (int e = 0; e < 4; ++e) {
                float cres[2][2][4];
#pragma unroll
                for (int bj = 0; bj < 2; ++bj) {
                    float w0 = cwv[bj][0][e], w1 = cwv[bj][1][e], w2 = cwv[bj][2][e], bb = cwv[bj][3][e];
                    asm volatile("" : "+v"(w0), "+v"(w1), "+v"(w2), "+v"(bb));
#pragma unroll
                    for (int ai = 0; ai < 2; ++ai) {
                        const int seg = 2 * ai + wr, sp = seg > 0 ? seg - 1 : 0;
                        float h0 = xch[(sp * 2 + 0) * 256 + bj * 128 + ccol + 4 * n + e], h1 = xch[(sp * 2 + 1) * 256 + bj * 128 + ccol + 4 * n + e];
                        h0 = seg > 0 ? h0 : 0.f; h1 = seg > 0 ? h1 : 0.f;
                        float a1p = 0.f, a2p = 0.f;
#pragma unroll
                        for (int m = 0; m < 4; ++m) {
                            float uu = acc[ai][bj][m][n][e];
                            asm volatile("" : "+v"(uu));
                            const float a1 = dppf<0x121>(uu), a2 = dppf<0x122>(uu);
                            float p1, p2;
                            if (m == 0) { p1 = f0 ? h1 : a1; p2 = f0 ? h0 : (f1 ? h1 : a2); }
                            else { p1 = f0 ? a1p : a1; p2 = (f0 || f1) ? a2p : a2; }
                            a1p = a1; a2p = a2;
                            p1 = ((mk0 >> (4 * ai + m)) & 1u) ? 0.f : p1; p2 = ((mk1 >> (4 * ai + m)) & 1u) ? 0.f : p2;
                            cres[bj][ai][m] = bb + w0 * p2 + w1 * p1 + w2 * uu;
                        }
                    }
                }
#pragma unroll
                for (int ai = 0; ai < 2; ++ai)
#pragma unroll
                    for (int m = 0; m < 4; ++m) { const float gt = cres[0][ai][m]; float rr = gt * sigmoidf_(gt) * cres[1][ai][m]; asm volatile("" : "+v"(rr)); acc[ai][0][m][n][e] = rr; }
            }
        }
#pragma unroll
        for (int ai = 0; ai < 2; ++ai)
#pragma unroll
            for (int m = 0; m < 4; ++m) {
                const int rl = ai * 128 + wr * 64 + m * 16 + fr; const int R = u.pm * 254 - 2 + rl;
                if (rl >= 2 && R < MROWS) { const f32x4 v0 = acc[ai][0][m][0], v1 = acc[ai][0][m][1];
                    u32x4 w; w.x = pk2(v0[0], v0[1]); w.y = pk2(v0[2], v0[3]); w.z = pk2(v1[0], v1[1]); w.w = pk2(v1[2], v1[3]); *(u32x4*)(Act + (size_t)R * DFF + ffbase) = w; }
            }
    }
};
}

typedef float f32x2v __attribute__((ext_vector_type(2)));
__device__ __forceinline__ int cvt_seg(const float* __restrict__ src, int ldsrc, int col0, bf16_t* __restrict__ dst, int K, int row0, int ncols, int mode, float* tile, int rot) {
    int tid; asm volatile("v_mov_b32 %0, %1" : "=v"(tid) : "v"((int)threadIdx.x));
    const int G = (int)gridDim.x;
    const int nkt = K / 64, njt = (ncols + 255) / 256, nit = nkt * njt;
    const int vb = ((int)blockIdx.x - rot + G) % G;
    const int j4 = tid & 63, k0 = tid >> 6, jj = tid >> 3, kg = tid & 7;
    constexpr int TS_ = 258;
    f32x4 v[8];
#define CVT_LOAD(it_) do { const int kt_ = (it_) % nkt, jt_ = (it_) / nkt, kb_ = kt_ * 64, j_ = jt_ * 256 + 4 * j4; int sc_ = col0 + j_; \
        if (mode == 1) { const int pn_ = j_ >> 8, jl_ = j_ & 255; sc_ = (jl_ < 128) ? 128 * pn_ + jl_ : DFF + 128 * pn_ + (jl_ - 128); } \
        _Pragma("unroll") for (int p = 0; p < 8; ++p) { v[p] = (f32x4){0.f, 0.f, 0.f, 0.f}; if (j_ < ncols) v[p] = *(const f32x4*)(src + (size_t)(kb_ + k0 + 8 * p) * ldsrc + sc_); } } while (0)
    int it = vb;
    if (it < nit) CVT_LOAD(it);
    for (; it < nit; it += G) {
        const int kt = it % nkt, jt = it / nkt, kb = kt * 64, jb = jt * 256;
#pragma unroll
        for (int p = 0; p < 8; ++p) { float* tp = tile + (k0 + 8 * p) * TS_ + 4 * j4; *(f32x2v*)tp = (f32x2v){v[p][0], v[p][1]}; *(f32x2v*)(tp + 2) = (f32x2v){v[p][2], v[p][3]}; }
        __syncthreads();
        if (it + G < nit) CVT_LOAD(it + G);
#pragma unroll
        for (int q = 0; q < 4; ++q) { const int jo = jj + 64 * q;
            if (jb + jo < ncols) { u32x4 w; const float* tp = tile + (8 * kg) * TS_ + jo;
                w.x = pk2(tp[0], tp[TS_]); w.y = pk2(tp[2 * TS_], tp[3 * TS_]); w.z = pk2(tp[4 * TS_], tp[5 * TS_]); w.w = pk2(tp[6 * TS_], tp[7 * TS_]);
                *(u32x4*)(dst + (size_t)(row0 + jb + jo) * K + kb + 8 * kg) = w; } }
        __syncthreads();
    }
#undef CVT_LOAD
    return (rot + nit) % G;
}
__device__ __forceinline__ void convert_weights(const Args& a, int l, unsigned char* wb, float* tile) {
    const float* win = a.in[3] + (size_t)l * 1024 * 8464;
    bf16_t* WIN = (bf16_t*)(wb + WB_WIN);
    int r = 0;
    r = cvt_seg(win, 8464, 0, WIN, 1024, 0, 1024, 0, tile, r);
    r = cvt_seg(win, 8464, 1040, WIN, 1024, 1024, 512, 0, tile, r);
    r = cvt_seg(win, 8464, 1552, WIN, 1024, 1536, 2048, 0, tile, r);
    r = cvt_seg(win, 8464, 6672, WIN, 1024, 3584, 512, 0, tile, r);
    r = cvt_seg(win, 8464, 7248, WIN, 1024, 4096, 1024, 0, tile, r);
    r = cvt_seg(win, 8464, 7184, WIN, 1024, 5120, 64, 0, tile, r);
    r = cvt_seg(win, 8464, 8272, WIN, 1024, 5184, 192, 0, tile, r);
    if (l == 1) r = cvt_seg(a.in[4], 32, 0, WIN, 1024, 5376, 32, 0, tile, r);
    r = cvt_seg(win, 8464, 1024, WIN, 1024, 5408, 16, 0, tile, r);
    r = cvt_seg(win, 8464, 3600, (bf16_t*)(wb + WB_WG), 1024, 0, 3072, 0, tile, r);
    r = cvt_seg(a.in[24] + (size_t)l * 512 * 1024, 1024, 0, (bf16_t*)(wb + WB_WO), 512, 0, 1024, 0, tile, r);
    r = cvt_seg(a.in[25] + (size_t)l * 512 * 1024, 1024, 0, (bf16_t*)(wb + WB_WO) + 1024 * 512, 512, 0, 1024, 0, tile, r);
    r = cvt_seg(a.in[26] + (size_t)l * 512 * 1024, 1024, 0, (bf16_t*)(wb + WB_WO) + 2 * 1024 * 512, 512, 0, 1024, 0, tile, r);
    r = cvt_seg(a.in[27] + (size_t)l * 1024 * 1024, 1024, 0, (bf16_t*)(wb + WB_WOUT), 1024, 0, 1024, 0, tile, r);
    r = cvt_seg(a.in[29] + (size_t)l * 1024 * 5632, 5632, 0, (bf16_t*)(wb + WB_WUP), 1024, 0, 5632, 1, tile, r);
    r = cvt_seg(a.in[32] + (size_t)l * DFF * 1024, 1024, 0, (bf16_t*)(wb + WB_WDN), DFF, 0, 1024, 0, tile, r);
}
__device__ __forceinline__ void norm_rows(int mode, const float* x, const float* meta, float* z, const float* w, bf16_t* h, float* out) {
    int tid; asm volatile("v_mov_b32 %0, %1" : "=v"(tid) : "v"((int)threadIdx.x));
    const int lane = tid & 63, wave = tid >> 6;
    f32x4 wv[4];
#pragma unroll
    for (int i = 0; i < 4; ++i) wv[i] = *(const f32x4*)(w + lane * 4 + 256 * i);
    constexpr int RB = 4;
    for (int row0 = (blockIdx.x * 8 + wave) * RB; row0 < MROWS; row0 += gridDim.x * 8 * RB) {
        f32x4 v[RB][4];
#pragma unroll
        for (int r = 0; r < RB; ++r) {
            const int row = row0 + r, b = row / TS, t = row - b * TS;
            const float* src = (mode == 0) ? (t < 16 ? meta + (size_t)t * 1024 : x + ((size_t)b * 2048 + (t - 16)) * 1024) : z + (size_t)row * 1024;
#pragma unroll
            for (int i = 0; i < 4; ++i) v[r][i] = *(const f32x4*)(src + lane * 4 + 256 * i);
        }
#pragma unroll
        for (int r = 0; r < RB; ++r) {
            const int row = row0 + r, b = row / TS, t = row - b * TS;
            float ss = 0.f;
#pragma unroll
            for (int i = 0; i < 4; ++i) ss += v[r][i][0] * v[r][i][0] + v[r][i][1] * v[r][i][1] + v[r][i][2] * v[r][i][2] + v[r][i][3] * v[r][i][3];
            ss = wave_sum(ss);
            const float rstd = __builtin_amdgcn_rsqf(ss * (1.0f / 1024.0f) + 1e-6f);
            if (mode == 2 && t < 16) continue;
#pragma unroll
            for (int i = 0; i < 4; ++i) {
                if (mode == 0) *(f32x4*)(z + (size_t)row * 1024 + lane * 4 + 256 * i) = v[r][i];
                const f32x4 y = v[r][i] * rstd * wv[i];
                if (mode == 2) *(f32x4*)(out + ((size_t)b * 2048 + (t - 16)) * 1024 + lane * 4 + 256 * i) = y;
                else { u32x2 p; p.x = pk2(y[0], y[1]); p.y = pk2(y[2], y[3]); *(u32x2*)(h + (size_t)row * 1024 + lane * 4 + 256 * i) = p; }
            }
        }
    }
}

__device__ __forceinline__ f32x4 mfma16(bf16x8 a, bf16x8 b, f32x4 c) { return __builtin_amdgcn_mfma_f32_16x16x32_bf16(a, b, c, 0, 0, 0); }
template <int DK, bool HG>
__device__ __forceinline__ void gla_unit(unsigned char* lds, bf16_t* P, int b, int h, int layer, const Args& a, bool st = true) {
    constexpr int NG = 512 / DK, RPG = 32 / NG, LQ = DK + 8, NA = DK / 16;
    bf16_t* RAWQ = (bf16_t*)lds; bf16_t* RAWK = RAWQ + 32 * DK; bf16_t* RAWV = RAWK + 32 * DK; bf16_t* RAWX = RAWV + 32 * 128;
    bf16_t* QT = RAWX + 32 * 16; bf16_t* KT = QT + 32 * LQ; bf16_t* QH = KT + 32 * LQ; bf16_t* KHT = QH + 32 * LQ; bf16_t* VT = KHT + DK * 40; bf16_t* SC = VT + 128 * 40;
    float* DEC = (float*)(SC + 32 * 40); float* TOT = DEC + DK; float* RED = TOT + NG * DK;
    int tid; asm volatile("v_mov_b32 %0, %1" : "=v"(tid) : "v"((int)threadIdx.x));
    const int lane = tid & 63, w = tid >> 6, l16 = lane & 15, g4 = lane >> 4;
    const int qcol = HG ? PC_HQ + 128 * h : PC_GQ + 64 * h, kcol = HG ? PC_HF + 128 * h : PC_GK + 64 * h, vcol = HG ? PC_HI + 128 * h : PC_GV + 128 * h, gcol = HG ? PC_HG + 128 * h : PC_GG + 128 * h;
    const size_t rowbase = (size_t)b * TS;
    const int d = tid % DK, rg = tid / DK;
    float lb = 0.f, up[16], bias = 0.f;
    if (HG) { if (layer == 1) { const float l0 = a.in[22][h * 128 + d], l1 = a.in[22][512 + h * 128 + d]; lb = sigmoidf_(l1 - l0); } }
    else {
#pragma unroll
        for (int j = 0; j < 16; ++j) up[j] = a.in[7][(size_t)layer * 16 * 256 + j * 256 + 64 * h + d];
        bias = a.in[8][layer * 256 + 64 * h + d];
    }
    const float onemlb = 1.0f - lb;
    const float nw = (HG ? a.in[23] : a.in[9])[layer * 128 + 16 * w + l16];
    f32x4 S[NA];
#pragma unroll
    for (int i = 0; i < NA; ++i) S[i] = (f32x4){0.f, 0.f, 0.f, 0.f};
    constexpr int QP = DK / 8;
    const bool hasq = tid < 32 * QP;
    const int qrow = tid / QP, qcg = tid % QP, vrow = tid >> 4, vcg = tid & 15;
    u32x4 rq, rk, rv, rx;
    unsigned short gpre[8], gcur[8];
#pragma unroll
    for (int i = 0; i < 8; ++i) { gpre[i] = 0; gcur[i] = 0; }
    unsigned short fv[8];
#pragma unroll
    for (int i = 0; i < 8; ++i) fv[i] = 0;
    auto load_chunk = [&](int n) {
        const u32x4 zz = (u32x4){0u, 0u, 0u, 0u}; rq = zz; rk = zz; rv = zz; rx = zz;
        if (hasq) { const int t = 32 * n + qrow - 16; if (t >= 0) { const bf16_t* rp = P + (rowbase + t) * LDP; rq = *(const u32x4*)(rp + qcol + 8 * qcg); if (!HG) rk = *(const u32x4*)(rp + kcol + 8 * qcg); } }
        if (HG) {
#pragma unroll
            for (int r = 0; r < 8; ++r) { const int t = 32 * n + (rg * 8 + r) - 16; fv[r] = 0; if (t >= 0) fv[r] = P[(rowbase + t) * LDP + kcol + d]; }
        }
        { const int t = 32 * n + vrow - 16; if (t >= 0) rv = *(const u32x4*)(P + (rowbase + t) * LDP + vcol + 8 * vcg); }
        if (!HG && tid < 64) { const int t = 32 * n + (tid >> 1) - 16; if (t >= 0) rx = *(const u32x4*)(P + (rowbase + t) * LDP + PC_GGK + 8 * (tid & 1)); }
#pragma unroll
        for (int i = 0; i < 8; ++i) { const int t = 32 * n + 16 * (i >> 2) + 4 * g4 + (i & 3) - 16; gpre[i] = 0; if (t >= 0) gpre[i] = P[(rowbase + t) * LDP + gcol + 16 * w + l16]; }
    };
    load_chunk(0);
    for (int n = 0; n < 65; ++n) {
        if (hasq) { *(u32x4*)(RAWQ + qrow * DK + 8 * qcg) = rq; if (!HG) *(u32x4*)(RAWK + qrow * DK + 8 * qcg) = rk; }
        *(u32x4*)(RAWV + vrow * 128 + 8 * vcg) = rv;
        if (!HG && tid < 64) *(u32x4*)(RAWX + (tid >> 1) * 16 + 8 * (tid & 1)) = rx;
        if (!HG) __syncthreads();
#pragma unroll
        for (int i = 0; i < 8; ++i) gcur[i] = gpre[i];
        if (!HG) { if (n + 1 < 65) load_chunk(n + 1); }
        float cum[RPG], kv[RPG]; float run = 0.f;
#pragma unroll
        for (int r = 0; r < RPG; ++r) {
            const int i = rg * RPG + r; const bool valid = (n > 0) || (i >= 16);
            float gg, kk;
            if (HG) { const float zf = bf2f(fv[r]); const float ez = __expf(fminf(-zf, 80.f)); const float sg = __builtin_amdgcn_rcpf(1.0f + ez); gg = __logf(fmaxf(lb + onemlb * sg, 1e-30f)); kk = onemlb * ez * sg; }
            else { float xx = bias;
                const u32x4 g0 = *(const u32x4*)(RAWX + i * 16), g1 = *(const u32x4*)(RAWX + i * 16 + 8);
                xx += bflo(g0.x) * up[0] + bfhi(g0.x) * up[1] + bflo(g0.y) * up[2] + bfhi(g0.y) * up[3] + bflo(g0.z) * up[4] + bfhi(g0.z) * up[5] + bflo(g0.w) * up[6] + bfhi(g0.w) * up[7];
                xx += bflo(g1.x) * up[8] + bfhi(g1.x) * up[9] + bflo(g1.y) * up[10] + bfhi(g1.y) * up[11] + bflo(g1.z) * up[12] + bfhi(g1.z) * up[13] + bflo(g1.w) * up[14] + bfhi(g1.w) * up[15];
                gg = -softplusf_(-xx) * (1.0f / 16.0f); kk = bf2f(RAWK[i * DK + d]); }
            if (!valid) { gg = 0.f; kk = 0.f; }
            run += gg; cum[r] = run; kv[r] = kk;
        }
        if (HG) { if (n + 1 < 65) load_chunk(n + 1); }
        TOT[rg * DK + d] = run;
        __syncthreads();
        {
            float off = 0.f, bref = 0.f, blast = 0.f;
#pragma unroll
            for (int q = 0; q < NG; ++q) { const float tq = TOT[q * DK + d]; if (q < rg) off += tq; if (q < NG / 2) bref += tq; blast += tq; }
            unsigned short kh[RPG];
            const float ebref = __expf(bref), ebl = __expf(blast - bref);
#pragma unroll
            for (int r = 0; r < RPG; ++r) {
                const int i = rg * RPG + r; const float bb = off + cum[r];
                const float qv = bf2f(RAWQ[i * DK + d]) * (HG ? 1.0f : 0.125f);
                const float e1 = __expf(bb - bref), e2 = __builtin_amdgcn_rcpf(e1);
                const float qt = qv * e1, kt = kv[r] * e2;
                const unsigned p1 = pk2(qt, kt), p2 = pk2(qt * ebref, kt * ebl);
                QT[i * LQ + d] = (bf16_t)(p1 & 0xffffu); KT[i * LQ + d] = (bf16_t)(p1 >> 16);
                QH[i * LQ + d] = (bf16_t)(p2 & 0xffffu); kh[r] = (unsigned short)(p2 >> 16);
            }
            if (RPG == 8) { u32x4 wv; wv.x = kh[0] | ((unsigned)kh[1] << 16); wv.y = kh[2] | ((unsigned)kh[3] << 16); wv.z = kh[4 % RPG] | ((unsigned)kh[5 % RPG] << 16); wv.w = kh[6 % RPG] | ((unsigned)kh[7 % RPG] << 16); *(u32x4*)(KHT + d * 40 + rg * 8) = wv; }
            else { u32x2 wv; wv.x = kh[0] | ((unsigned)kh[1] << 16); wv.y = kh[2] | ((unsigned)kh[3] << 16); *(u32x2*)(KHT + d * 40 + rg * 4) = wv; }
            if (rg == 0) DEC[d] = __expf(blast);
            const int dv = tid & 127, rgv = tid >> 7;
            unsigned short vv[8];
#pragma unroll
            for (int r = 0; r < 8; ++r) vv[r] = RAWV[(8 * rgv + r) * 128 + dv];
            u32x4 wv; wv.x = vv[0] | ((unsigned)vv[1] << 16); wv.y = vv[2] | ((unsigned)vv[3] << 16); wv.z = vv[4] | ((unsigned)vv[5] << 16); wv.w = vv[6] | ((unsigned)vv[7] << 16);
            *(u32x4*)(VT + dv * 40 + 8 * rgv) = wv;
        }
        __syncthreads();
        f32x4 O[2];
#pragma unroll
        for (int rt = 0; rt < 2; ++rt) {
            O[rt] = (f32x4){0.f, 0.f, 0.f, 0.f};
#pragma unroll
            for (int ks = 0; ks < DK / 32; ++ks) {
                const bf16x4 lo = *(const bf16x4*)(QH + (16 * rt + l16) * LQ + 32 * ks + 4 * g4), hi = *(const bf16x4*)(QH + (16 * rt + l16) * LQ + 32 * ks + 16 + 4 * g4);
                const bf16x8 B = pk8(S[2 * ks], S[2 * ks + 1]);
                O[rt] = mfma16(__builtin_shufflevector(lo, hi, 0, 1, 2, 3, 4, 5, 6, 7), B, O[rt]);
            }
        }
        {
            f32x4 s00 = (f32x4){0.f, 0.f, 0.f, 0.f}, s10 = s00, s11 = s00;
#pragma unroll
            for (int ks = 0; ks < DK / 32; ++ks) {
                const bf16x8 q0 = *(const bf16x8*)(QT + l16 * LQ + 32 * ks + 8 * g4), q1 = *(const bf16x8*)(QT + (16 + l16) * LQ + 32 * ks + 8 * g4);
                const bf16x8 k0 = *(const bf16x8*)(KT + l16 * LQ + 32 * ks + 8 * g4), k1 = *(const bf16x8*)(KT + (16 + l16) * LQ + 32 * ks + 8 * g4);
                s00 = mfma16(k0, q0, s00); s10 = mfma16(k0, q1, s10); s11 = mfma16(k1, q1, s11);
            }
#pragma unroll
            for (int e = 0; e < 4; ++e) { const bool keep = l16 >= 4 * g4 + e; s00[e] = keep ? s00[e] : 0.f; s11[e] = keep ? s11[e] : 0.f; }
            const u32x4 a0w = (u32x4){pk2(s00[0], s00[1]), pk2(s00[2], s00[3]), 0u, 0u};
            const u32x4 a1w = (u32x4){pk2(s10[0], s10[1]), pk2(s10[2], s10[3]), pk2(s11[0], s11[1]), pk2(s11[2], s11[3])};
            const bf16x4 vlo = *(const bf16x4*)(VT + (16 * w + l16) * 40 + 4 * g4), vhi = *(const bf16x4*)(VT + (16 * w + l16) * 40 + 16 + 4 * g4);
            const bf16x8 Bvp = __builtin_shufflevector(vlo, vhi, 0, 1, 2, 3, 4, 5, 6, 7);
            O[0] = mfma16(__builtin_bit_cast(bf16x8, a0w), Bvp, O[0]); O[1] = mfma16(__builtin_bit_cast(bf16x8, a1w), Bvp, O[1]);
            const bf16x8 Bv = *(const bf16x8*)(VT + (16 * w + l16) * 40 + 8 * g4);
#pragma unroll
            for (int i = 0; i < NA; ++i) { const f32x4 dc = *(const f32x4*)(DEC + 16 * i + 4 * g4); S[i] = S[i] * dc; const bf16x8 A = *(const bf16x8*)(KHT + (16 * i + l16) * 40 + 8 * g4); S[i] = mfma16(A, Bv, S[i]); }
#pragma unroll
            for (int rt = 0; rt < 2; ++rt)
#pragma unroll
                for (int e = 0; e < 4; ++e) { const float sq = red16(O[rt][e] * O[rt][e]); if (l16 == 0) RED[w * 32 + 16 * rt + 4 * g4 + e] = sq; }
        }
        __syncthreads();
#pragma unroll
        for (int rt = 0; rt < 2; ++rt) {
            f32x4 tot4 = *(const f32x4*)(RED + 16 * rt + 4 * g4);
#pragma unroll
            for (int q = 1; q < 8; ++q) tot4 = tot4 + *(const f32x4*)(RED + q * 32 + 16 * rt + 4 * g4);
#pragma unroll
            for (int e = 0; e < 4; ++e) {
                const int i = 16 * rt + 4 * g4 + e, t = 32 * n + i - 16;
                const float rstd = __builtin_amdgcn_rsqf(tot4[e] * (1.0f / 128.0f) + 1e-6f);
                if (t >= 0 && st) { bf16_t* gp = P + (rowbase + t) * LDP + gcol + 16 * w + l16; const float gt = bf2f(gcur[4 * rt + e]); *gp = (bf16_t)f2bf(O[rt][e] * rstd * nw * gt * sigmoidf_(gt)); }
            }
        }
    }
}

__device__ __forceinline__ bf16x8 load_bfrag(const float* W, int s, int g4, int C) {
    bf16x8 r;
#pragma unroll
    for (int j = 0; j < 8; ++j) r[j] = (short)f2bf(W[(size_t)(32 * s + 8 * g4 + j) * 512 + C]);
    return r;
}
__device__ __forceinline__ void rwkv_unit(unsigned char* lds, bf16_t* P, bf16_t* VF, int b, int h, int layer, const Args& a, bool st = true) {
    bf16_t* SW = (bf16_t*)lds; bf16_t* SA = SW + 32 * 72; bf16_t* SG = SA + 32 * 72; bf16_t* SVR = SG + 32 * 136;
    constexpr int FS = 68; float* LG = (float*)(SVR + 32 * 40); float* GG = LG + 32 * FS; float* AA = GG + 32 * FS; float* VG = AA + 32 * FS; float* Y = VG + 32 * FS;
    float* BON = Y + 32 * FS; float* GC = BON + 32; float* LAB = GC + 128; float* CST = LAB + 512;
    bf16_t* Abf = (bf16_t*)(CST + 800); bf16_t* Qbf = Abf + 32 * 72; bf16_t* Bbf = Qbf + 32 * 72; bf16_t* Cbf = Bbf + 32 * 72;
    constexpr int LT = 36; bf16_t* BT = Cbf + 32 * 72; bf16_t* CT = BT + 64 * LT; bf16_t* VmT = CT + 64 * LT;
    bf16_t* LAC = VmT + 64 * LT + 64; bf16_t* MQB = LAC + 512; bf16_t* MQC = MQB + 512; bf16_t* TT = MQC + 512;
    constexpr int RS = 488;
    bf16_t* RAWC = TT + 512; bf16_t* CARRY = RAWC + 32 * RS;
    int tid; asm volatile("v_mov_b32 %0, %1" : "=v"(tid) : "v"((int)threadIdx.x));
    const int lane = tid & 63, w = tid >> 6, l16 = lane & 15, g4 = lane >> 4;
    const size_t rowbase = (size_t)b * TS;
    const int ti = tid >> 4, q = tid & 15, C4 = 64 * h + 4 * q;
    {
        const float* mu = a.in[5] + (size_t)layer * 1792;
        if (tid < 64) { const int C = 64 * h + tid;
            CST[tid] = mu[C]; CST[64 + tid] = mu[576 + C]; CST[128 + tid] = mu[1088 + C];
            CST[192 + tid] = a.in[17][layer * 512 + C]; CST[256 + tid] = a.in[18][layer * 512 + C]; CST[320 + tid] = a.in[19][layer * 512 + C];
            CST[384 + tid] = a.in[20][layer * 512 + C]; CST[448 + tid] = a.in[21][layer * 512 + C];
            CST[512 + tid] = mu[512 + tid]; CST[576 + tid] = mu[1600 + tid]; }
        if (tid < 128) CST[640 + tid] = mu[1664 + tid];
        if (tid < 32) CST[768 + tid] = (layer == 1) ? a.in[6][tid] : 0.f;
    }
    const int rt = w >> 2, ct = w & 3, Cm = 64 * h + 16 * ct + l16;
    bf16x8 Bw[2], Ba[2], Bg[4], Bvr;
#pragma unroll
    for (int s = 0; s < 2; ++s) { Bw[s] = load_bfrag(a.in[11] + (size_t)layer * 64 * 512, s, g4, Cm); Ba[s] = load_bfrag(a.in[13] + (size_t)layer * 64 * 512, s, g4, Cm); }
#pragma unroll
    for (int s = 0; s < 4; ++s) Bg[s] = load_bfrag(a.in[16] + (size_t)layer * 128 * 512, s, g4, Cm);
    Bvr = (bf16x8){0, 0, 0, 0, 0, 0, 0, 0};
    float v0c = 0.f;
    if (layer == 1) { Bvr = load_bfrag(a.in[15], 0, g4, Cm); v0c = a.in[14][Cm]; }
    const float w0c = a.in[10][layer * 512 + Cm], a0c = a.in[12][layer * 512 + Cm];
    f32x4 ST[4];
#pragma unroll
    for (int j = 0; j < 4; ++j) ST[j] = (f32x4){0.f, 0.f, 0.f, 0.f};
    u32x2 n_r, n_k, n_v, n_w, n_a, n_vf; u32x4 n_g; unsigned n_vr;
#define RW_LOAD_RAW(cc) do { const int t_ = 32 * (cc) + ti; const u32x2 z2_ = (u32x2){0u, 0u}; n_r = z2_; n_k = z2_; n_v = z2_; n_w = z2_; n_a = z2_; n_vf = z2_; n_g = (u32x4){0u, 0u, 0u, 0u}; n_vr = 0u; \
        if (t_ < TS) { const bf16_t* rp_ = P + (rowbase + t_) * LDP; n_r = *(const u32x2*)(rp_ + PC_RR + C4); n_k = *(const u32x2*)(rp_ + PC_RK + C4); n_v = *(const u32x2*)(rp_ + PC_RV + C4); \
            n_w = *(const u32x2*)(rp_ + PC_RW + 4 * q); n_a = *(const u32x2*)(rp_ + PC_RA + 4 * q); n_g = *(const u32x4*)(rp_ + PC_RG + 8 * q); n_vr = *(const unsigned*)(rp_ + PC_RVR + 2 * q); \
            if (layer == 1) n_vf = *(const u32x2*)(VF + (rowbase + t_) * 512 + C4); } } while (0)
#define BF4(u) ((f32x4){bflo((u).x), bfhi((u).x), bflo((u).y), bfhi((u).y)})
    RW_LOAD_RAW(0);

    for (int c = 0; c < 65; ++c) {
        const int t0 = 32 * c, t = t0 + ti; const bool valid = t < TS;
        f32x4 r4 = (f32x4){0.f, 0.f, 0.f, 0.f}, k4 = r4, v4 = r4, vf4 = r4;
        {
            bf16_t* rw = RAWC + ti * RS;
            *(u32x2*)(rw + 4 * q) = n_r; *(u32x2*)(rw + 64 + 4 * q) = n_k; *(u32x2*)(rw + 128 + 4 * q) = n_v; *(u32x2*)(rw + 192 + 4 * q) = n_w; *(u32x2*)(rw + 256 + 4 * q) = n_a;
            *(u32x4*)(rw + 320 + 8 * q) = n_g; *(unsigned*)(rw + 448 + 2 * q) = n_vr;
            if (ti == 31) { bf16_t* cw_ = CARRY + (c & 1) * RS;
                *(u32x2*)(cw_ + 4 * q) = n_r; *(u32x2*)(cw_ + 64 + 4 * q) = n_k; *(u32x2*)(cw_ + 128 + 4 * q) = n_v; *(u32x2*)(cw_ + 192 + 4 * q) = n_w; *(u32x2*)(cw_ + 256 + 4 * q) = n_a;
                *(u32x4*)(cw_ + 320 + 8 * q) = n_g; *(unsigned*)(cw_ + 448 + 2 * q) = n_vr; }
            vf4 = BF4(n_vf);
        }
        __syncthreads();
        if (c + 1 < 65) RW_LOAD_RAW(c + 1);
        {
            const bf16_t* cu = RAWC + ti * RS; const bf16_t* pv = (ti > 0) ? cu - RS : CARRY + ((c + 1) & 1) * RS;
            const bool hasprev = t > 0;
            f32x4 sw = r4, sa = r4, sg0 = r4, sg1 = r4; float sv0 = 0.f, sv1 = 0.f;
            if (valid) {
                const u32x2 z2 = (u32x2){0u, 0u};
                const u32x2 cr = *(const u32x2*)(cu + 4 * q), ck = *(const u32x2*)(cu + 64 + 4 * q), cv = *(const u32x2*)(cu + 128 + 4 * q), cwv = *(const u32x2*)(cu + 192 + 4 * q), cav = *(const u32x2*)(cu + 256 + 4 * q);
                const u32x4 cgv = *(const u32x4*)(cu + 320 + 8 * q); const unsigned cvr = *(const unsigned*)(cu + 448 + 2 * q);
                u32x2 pr = z2, pk = z2, pvv = z2, pwv = z2, pav = z2; u32x4 pgv = (u32x4){0u, 0u, 0u, 0u}; unsigned pvr = 0u;
                if (hasprev) { pr = *(const u32x2*)(pv + 4 * q); pk = *(const u32x2*)(pv + 64 + 4 * q); pvv = *(const u32x2*)(pv + 128 + 4 * q); pwv = *(const u32x2*)(pv + 192 + 4 * q); pav = *(const u32x2*)(pv + 256 + 4 * q);
                    pgv = *(const u32x4*)(pv + 320 + 8 * q); pvr = *(const unsigned*)(pv + 448 + 2 * q); }
                const f32x4 mu_r = *(const f32x4*)(CST + 4 * q), mu_k = *(const f32x4*)(CST + 64 + 4 * q), mu_v = *(const f32x4*)(CST + 128 + 4 * q);
                const f32x4 mu_w = *(const f32x4*)(CST + 512 + 4 * q), mu_a = *(const f32x4*)(CST + 576 + 4 * q), mu_g0 = *(const f32x4*)(CST + 640 + 8 * q), mu_g1 = *(const f32x4*)(CST + 644 + 8 * q);
                const float mu_vr0 = CST[768 + 2 * q], mu_vr1 = CST[769 + 2 * q];
                const f32x4 crf = BF4(cr), prf = BF4(pr); r4 = crf + (prf - crf) * mu_r;
                const f32x4 ckf = BF4(ck), pkf = BF4(pk); k4 = ckf + (pkf - ckf) * mu_k;
                const f32x4 cvf = BF4(cv), pvf = BF4(pvv); v4 = cvf + (pvf - cvf) * mu_v;
                const f32x4 cwf = BF4(cwv), pwf = BF4(pwv); sw = cwf + (pwf - cwf) * mu_w;
                const f32x4 caf = BF4(cav), paf = BF4(pav); sa = caf + (paf - caf) * mu_a;
                const f32x4 cg0 = (f32x4){bflo(cgv.x), bfhi(cgv.x), bflo(cgv.y), bfhi(cgv.y)}, pg0 = (f32x4){bflo(pgv.x), bfhi(pgv.x), bflo(pgv.y), bfhi(pgv.y)};
                const f32x4 cg1 = (f32x4){bflo(cgv.z), bfhi(cgv.z), bflo(cgv.w), bfhi(cgv.w)}, pg1 = (f32x4){bflo(pgv.z), bfhi(pgv.z), bflo(pgv.w), bfhi(pgv.w)};
                sg0 = cg0 + (pg0 - cg0) * mu_g0; sg1 = cg1 + (pg1 - cg1) * mu_g1;
                sv0 = bflo(cvr) + (bflo(pvr) - bflo(cvr)) * mu_vr0; sv1 = bfhi(cvr) + (bfhi(pvr) - bfhi(cvr)) * mu_vr1;
            }
            u32x2 o; o.x = pk2(tanhf_(sw[0]), tanhf_(sw[1])); o.y = pk2(tanhf_(sw[2]), tanhf_(sw[3])); *(u32x2*)(SW + ti * 72 + 4 * q) = o;
            o.x = pk2(sa[0], sa[1]); o.y = pk2(sa[2], sa[3]); *(u32x2*)(SA + ti * 72 + 4 * q) = o;
            u32x4 og; og.x = pk2(sigmoidf_(sg0[0]), sigmoidf_(sg0[1])); og.y = pk2(sigmoidf_(sg0[2]), sigmoidf_(sg0[3])); og.z = pk2(sigmoidf_(sg1[0]), sigmoidf_(sg1[1])); og.w = pk2(sigmoidf_(sg1[2]), sigmoidf_(sg1[3]));
            *(u32x4*)(SG + ti * 136 + 8 * q) = og;
            *(unsigned*)(SVR + ti * 40 + 2 * q) = (layer == 1) ? pk2(sv0, sv1) : 0u;
        }
        __syncthreads();
        {
            f32x4 cw = (f32x4){0.f, 0.f, 0.f, 0.f}, ca = cw, cgt = cw, cvv = cw;
#pragma unroll
            for (int s = 0; s < 2; ++s) { cw = mfma16(*(const bf16x8*)(SW + (16 * rt + l16) * 72 + 32 * s + 8 * g4), Bw[s], cw); ca = mfma16(*(const bf16x8*)(SA + (16 * rt + l16) * 72 + 32 * s + 8 * g4), Ba[s], ca); }
#pragma unroll
            for (int s = 0; s < 4; ++s) cgt = mfma16(*(const bf16x8*)(SG + (16 * rt + l16) * 136 + 32 * s + 8 * g4), Bg[s], cgt);
            if (layer == 1) cvv = mfma16(*(const bf16x8*)(SVR + (16 * rt + l16) * 40 + 8 * g4), Bvr, cvv);
            float lw[4];
#pragma unroll
            for (int e = 0; e < 4; ++e) {
                const int idx = (16 * rt + 4 * g4 + e) * FS + 16 * ct + l16;
                const float wl = -softplusf_(-(w0c + cw[e])) - 0.5f;
                lw[e] = (t0 + 16 * rt + 4 * g4 + e < TS) ? -__expf(wl) : 0.f;
                AA[idx] = sigmoidf_(a0c + ca[e]); GG[idx] = cgt[e]; VG[idx] = sigmoidf_(v0c + cvv[e]);
            }
            lw[1] += lw[0]; lw[2] += lw[1]; lw[3] += lw[2];
            float run = lw[3];
            { const float u1 = __shfl_up(run, 16, 64); if (g4 >= 1) run += u1; const float u2 = __shfl_up(run, 32, 64); if (g4 >= 2) run += u2; }
            const float excl = run - lw[3];
#pragma unroll
            for (int e = 0; e < 4; ++e) LG[(16 * rt + 4 * g4 + e) * FS + 16 * ct + l16] = excl + lw[e];
        }
        __syncthreads();
        {
            const f32x4 a4 = *(const f32x4*)(AA + ti * FS + 4 * q);
            if (layer == 1) { const f32x4 vg = *(const f32x4*)(VG + ti * FS + 4 * q); v4 = v4 + (vf4 - v4) * vg; }
            else if (valid && st) { u32x2 o; o.x = pk2(v4[0], v4[1]); o.y = pk2(v4[2], v4[3]); *(u32x2*)(VF + (rowbase + t) * 512 + C4) = o; }
            const f32x4 kkw = *(const f32x4*)(CST + 192 + 4 * q), kaw = *(const f32x4*)(CST + 256 + 4 * q), rkw = *(const f32x4*)(CST + 320 + 4 * q);
            f32x4 kk = k4 * kkw;
            const float ss = red16(kk[0] * kk[0] + kk[1] * kk[1] + kk[2] * kk[2] + kk[3] * kk[3]);
            kk = kk * fminf(__builtin_amdgcn_rsqf(ss), 1e12f);
            const f32x4 kp = k4 * (1.0f + (a4 - 1.0f) * kaw);
            const f32x4 rkp = r4 * kp * rkw;
            const float bon = red16(rkp[0] + rkp[1] + rkp[2] + rkp[3]);
            if (q == 0) BON[ti] = bon;
            const f32x4 lg = *(const f32x4*)(LG + ti * FS + 4 * q);
            f32x4 lgp = (f32x4){0.f, 0.f, 0.f, 0.f}; if ((ti & 15) != 0) lgp = *(const f32x4*)(LG + (ti - 1) * FS + 4 * q);
            f32x4 eg, egi, egp;
#pragma unroll
            for (int j = 0; j < 4; ++j) { eg[j] = __expf(lg[j]); egi[j] = __builtin_amdgcn_rcpf(eg[j]); egp[j] = __expf(lgp[j]); }
            f32x4 av = -(kk * egp), bv = kk * a4 * egi, cv = kp * egi, qv = r4 * eg, vv = v4;
            if (!valid) { const f32x4 zz = (f32x4){0.f, 0.f, 0.f, 0.f}; av = zz; bv = zz; cv = zz; qv = zz; vv = zz; }
            u32x2 o;
            o.x = pk2(av[0], av[1]); o.y = pk2(av[2], av[3]); *(u32x2*)(Abf + ti * 72 + 4 * q) = o;
            o.x = pk2(qv[0], qv[1]); o.y = pk2(qv[2], qv[3]); *(u32x2*)(Qbf + ti * 72 + 4 * q) = o;
            o.x = pk2(bv[0], bv[1]); o.y = pk2(bv[2], bv[3]); *(u32x2*)(Bbf + ti * 72 + 4 * q) = o;
#pragma unroll
            for (int j = 0; j < 4; ++j) BT[(4 * q + j) * LT + ti] = (bf16_t)(j & 1 ? (j == 1 ? o.x >> 16 : o.y >> 16) : (j == 0 ? o.x & 0xffffu : o.y & 0xffffu));
            o.x = pk2(cv[0], cv[1]); o.y = pk2(cv[2], cv[3]); *(u32x2*)(Cbf + ti * 72 + 4 * q) = o;
#pragma unroll
            for (int j = 0; j < 4; ++j) CT[(4 * q + j) * LT + ti] = (bf16_t)(j & 1 ? (j == 1 ? o.x >> 16 : o.y >> 16) : (j == 0 ? o.x & 0xffffu : o.y & 0xffffu));
            o.x = pk2(vv[0], vv[1]); o.y = pk2(vv[2], vv[3]);
#pragma unroll
            for (int j = 0; j < 4; ++j) VmT[(4 * q + j) * LT + ti] = (bf16_t)(j & 1 ? (j == 1 ? o.x >> 16 : o.y >> 16) : (j == 0 ? o.x & 0xffffu : o.y & 0xffffu));
            if ((ti & 15) == 15) *(f32x4*)(GC + (ti >> 4) * 64 + 4 * q) = eg;
        }
        __syncthreads();
        {
            const int sc = w >> 2, mat = w & 3;
            const bf16_t* X = (mat < 2 ? Abf : Qbf) + (16 * sc + l16) * 72; const bf16_t* Yp = ((mat & 1) ? Cbf : Bbf) + (16 * sc + l16) * 72;
            f32x4 d = (f32x4){0.f, 0.f, 0.f, 0.f};
#pragma unroll
            for (int s = 0; s < 2; ++s) d = mfma16(*(const bf16x8*)(X + 32 * s + 8 * g4), *(const bf16x8*)(Yp + 32 * s + 8 * g4), d);
            if (mat != 0) {
#pragma unroll
                for (int e = 0; e < 4; ++e) {
                    const int tt = 4 * g4 + e, ii = l16;
                    const bool keep = (mat < 2) ? (ii < tt) : (ii <= tt);
                    bf16_t* D = (mat == 1 ? LAC : (mat == 2 ? MQB : MQC)); D[sc * 256 + tt * 16 + ii] = (bf16_t)f2bf(keep ? d[e] : 0.f);
                }
            } else {
                f32x4 dT = (f32x4){0.f, 0.f, 0.f, 0.f};
#pragma unroll
                for (int s = 0; s < 2; ++s) dT = mfma16(*(const bf16x8*)(Yp + 32 * s + 8 * g4), *(const bf16x8*)(X + 32 * s + 8 * g4), dT);
                f32x4 X1, X1T, eye;
#pragma unroll
                for (int e = 0; e < 4; ++e) { const int r = 4 * g4 + e; X1[e] = (l16 < r) ? d[e] : 0.f; X1T[e] = (r < l16) ? dT[e] : 0.f; eye[e] = (r == l16) ? 1.f : 0.f; }
#define OPND(m) __builtin_bit_cast(bf16x8, ((u32x4){pk2((m)[0], (m)[1]), pk2((m)[2], (m)[3]), 0u, 0u}))
                const f32x4 zz = (f32x4){0.f, 0.f, 0.f, 0.f};
                const bf16x8 o1 = OPND(X1), o1t = OPND(X1T);
                const f32x4 X2 = mfma16(o1t, o1, zz), X2T = mfma16(o1, o1t, zz);
                const bf16x8 o2 = OPND(X2), o2t = OPND(X2T);
                const f32x4 X4 = mfma16(o2t, o2, zz), X4T = mfma16(o2, o2t, zz);
                const bf16x8 o4 = OPND(X4), o4t = OPND(X4T);
                const f32x4 X8 = mfma16(o4t, o4, zz);
                const f32x4 i2 = X2 + eye, i1t = X1T + eye, i4 = X4 + eye, i8 = X8 + eye;
                const f32x4 R1 = mfma16(OPND(i2), OPND(i1t), zz);
                const f32x4 R2 = mfma16(OPND(i4), OPND(R1), zz);
                const f32x4 R3 = mfma16(OPND(i8), OPND(R2), zz);
#undef OPND
                u32x2 o; o.x = pk2(R3[0], R3[1]); o.y = pk2(R3[2], R3[3]); *(u32x2*)(TT + sc * 256 + l16 * 16 + 4 * g4) = o;
            }
        }
        __syncthreads();
        if (w < 4) {
            const int nsc = (TS - t0) >= 32 ? 2 : 1;
            const bf16x4 z4 = (bf16x4){0, 0, 0, 0};
            for (int sc = 0; sc < nsc; ++sc) {
                const int tr = 16 * sc + l16;
                bf16x4 alo[2], ahi[2], qlo[2], qhi[2];
#pragma unroll
                for (int s = 0; s < 2; ++s) { alo[s] = *(const bf16x4*)(Abf + tr * 72 + 32 * s + 4 * g4); ahi[s] = *(const bf16x4*)(Abf + tr * 72 + 32 * s + 16 + 4 * g4);
                                              qlo[s] = *(const bf16x4*)(Qbf + tr * 72 + 32 * s + 4 * g4); qhi[s] = *(const bf16x4*)(Qbf + tr * 72 + 32 * s + 16 + 4 * g4); }
                const bf16x4 vm4 = *(const bf16x4*)(VmT + (16 * w + l16) * LT + 16 * sc + 4 * g4);
                const bf16x4 l4 = *(const bf16x4*)(LAC + sc * 256 + l16 * 16 + 4 * g4), t4 = *(const bf16x4*)(TT + sc * 256 + l16 * 16 + 4 * g4);
                const bf16x4 m1 = *(const bf16x4*)(MQB + sc * 256 + l16 * 16 + 4 * g4), m2 = *(const bf16x4*)(MQC + sc * 256 + l16 * 16 + 4 * g4);
                bf16x4 b4[4], c4v[4]; f32x4 gcv[4];
#pragma unroll
                for (int tm = 0; tm < 4; ++tm) { b4[tm] = *(const bf16x4*)(BT + (16 * tm + l16) * LT + 16 * sc + 4 * g4); c4v[tm] = *(const bf16x4*)(CT + (16 * tm + l16) * LT + 16 * sc + 4 * g4);
                                                 gcv[tm] = *(const f32x4*)(GC + sc * 64 + 16 * tm + 4 * g4); }
                const bf16x4 z4 = (bf16x4){0, 0, 0, 0};
                bf16x8 BS[2];
#pragma unroll
                for (int s = 0; s < 2; ++s) BS[s] = pk8(ST[2 * s], ST[2 * s + 1]);
                f32x4 rhs = (f32x4){0.f, 0.f, 0.f, 0.f}, yy = rhs;
#pragma unroll
                for (int s = 0; s < 2; ++s) {
                    rhs = mfma16(__builtin_shufflevector(alo[s], ahi[s], 0, 1, 2, 3, 4, 5, 6, 7), BS[s], rhs);
                    yy = mfma16(__builtin_shufflevector(qlo[s], qhi[s], 0, 1, 2, 3, 4, 5, 6, 7), BS[s], yy);
                }
                rhs = mfma16(__builtin_shufflevector(l4, z4, 0, 1, 2, 3, 4, 5, 6, 7), __builtin_shufflevector(vm4, z4, 0, 1, 2, 3, 4, 5, 6, 7), rhs);
                f32x4 uu = (f32x4){0.f, 0.f, 0.f, 0.f};
                { u32x4 rbw = (u32x4){pk2(rhs[0], rhs[1]), pk2(rhs[2], rhs[3]), 0u, 0u}; const bf16x8 rb = __builtin_bit_cast(bf16x8, rbw);
                  uu = mfma16(__builtin_shufflevector(t4, z4, 0, 1, 2, 3, 4, 5, 6, 7), rb, uu); }
                const u32x2 vmw = __builtin_bit_cast(u32x2, vm4);
                const u32x4 uvw = (u32x4){pk2(uu[0], uu[1]), pk2(uu[2], uu[3]), vmw.x, vmw.y};
                const bf16x8 UV = __builtin_bit_cast(bf16x8, uvw);
                yy = mfma16(__builtin_shufflevector(m1, m2, 0, 1, 2, 3, 4, 5, 6, 7), UV, yy);
#pragma unroll
                for (int tm = 0; tm < 4; ++tm) { ST[tm] = mfma16(__builtin_shufflevector(b4[tm], c4v[tm], 0, 1, 2, 3, 4, 5, 6, 7), UV, ST[tm]); ST[tm] = ST[tm] * gcv[tm]; }
#pragma unroll
                for (int e = 0; e < 4; ++e) Y[(16 * sc + 4 * g4 + e) * FS + 16 * w + l16] = yy[e];
            }
        }
        __syncthreads();
        {
            const f32x4 y4 = *(const f32x4*)(Y + ti * FS + 4 * q), gg = *(const f32x4*)(GG + ti * FS + 4 * q);
            const float mean = red16(y4[0] + y4[1] + y4[2] + y4[3]) * (1.0f / 64.0f);
            const f32x4 dd = y4 - mean;
            const float var = red16(dd[0] * dd[0] + dd[1] * dd[1] + dd[2] * dd[2] + dd[3] * dd[3]) * (1.0f / 64.0f);
            const f32x4 lnw = *(const f32x4*)(CST + 384 + 4 * q), lnb = *(const f32x4*)(CST + 448 + 4 * q);
            const f32x4 yn = dd * __builtin_amdgcn_rsqf(var + 64e-5f) * lnw + lnb;
            const f32x4 o4 = (yn + v4 * BON[ti]) * gg;
            if (valid && st) { u32x2 o; o.x = pk2(o4[0], o4[1]); o.y = pk2(o4[2], o4[3]); *(u32x2*)(P + (rowbase + t) * LDP + PC_RR + C4) = o; }
        }
    }
}

#ifdef PROBE_CLASS
__device__ __forceinline__ void probe_scale_rows(const float* w, float* wout, float s) { for (int i = threadIdx.x; i < 1024; i += NTHR) wout[i] = w[i] * s; __syncthreads(); }
#endif
#define XB_TMO      128
#define XB_XCNT(j)  (256  + 64 * (j))
#define XB_XSUB(j)  (1280 + 64 * (j))
#define XB_XGEN(j)  (2304 + 64 * (j))
#define XB_TOP      3328
#define XB_TOPGEN   3392
#define XCD_BAR_WORDS 3456
#define XB_SPIN_CAP (1u << 18)

__device__ __forceinline__ unsigned xb_ld(unsigned* p)              { return __hip_atomic_load(p, __ATOMIC_RELAXED, __HIP_MEMORY_SCOPE_AGENT); }
__device__ __forceinline__ unsigned xb_add(unsigned* p, unsigned v) { return __hip_atomic_fetch_add(p, v, __ATOMIC_RELAXED, __HIP_MEMORY_SCOPE_AGENT); }
__device__ __forceinline__ unsigned xb_xcc_id() { return (unsigned)__builtin_amdgcn_s_getreg((3 << 11) | 20) & 0xFu; }
#define XB_SPIN(cond, bar) do { unsigned _sp = 0; while (cond) { __builtin_amdgcn_s_sleep(1); \
    if ((++_sp & 255u) == 0u) { if (xb_ld(&(bar)[XB_TMO])) break; if (_sp > XB_SPIN_CAP) { atomicAdd(&(bar)[XB_TMO], 1u); break; } } } } while (0)

struct XcdBarrier {
    unsigned* bar; unsigned x;
    volatile LAS unsigned* st;
};

__device__ __forceinline__ XcdBarrier xcd_barrier_post(unsigned* bar, volatile LAS unsigned* st) {
    XcdBarrier b; b.bar = bar; b.x = xb_xcc_id(); b.st = st;
    if (threadIdx.x == 0) (void)xb_add(&bar[XB_XCNT(b.x)], 1u);
    return b;
}
__device__ __forceinline__ void xcd_barrier_complete(unsigned* bar, unsigned x, unsigned& nloc, unsigned& nx) {
    const unsigned G = gridDim.x * gridDim.y * gridDim.z;
    unsigned sum, cnt, mine, sp = 0u;
    for (;;) {
        sum = 0u; cnt = 0u; mine = 0u;
#pragma unroll
        for (unsigned j = 0; j < 16; ++j) { const unsigned c = xb_ld(&bar[XB_XCNT(j)]); sum += c; cnt += (c > 0u) ? 1u : 0u; mine = (j == x) ? c : mine; }
        if (sum == G) break;
        __builtin_amdgcn_s_sleep(1);
        if ((++sp & 255u) == 0u) { if (xb_ld(&bar[XB_TMO])) break; if (sp > XB_SPIN_CAP) { atomicAdd(&bar[XB_TMO], 1u); break; } }
    }
    nloc = mine > 0u ? mine : 1u; nx = cnt > 0u ? cnt : 1u;
}

__device__ __forceinline__ void xcd_barrier(const XcdBarrier& b) {
    asm volatile("s_waitcnt vmcnt(0)" ::: "memory");
    __syncthreads();
    if (threadIdx.x == 0) {
        unsigned* bar = b.bar;
        __builtin_amdgcn_s_waitcnt(0);
        unsigned nloc = b.st[0], nx = b.st[1];
        if (nloc == 0u) { xcd_barrier_complete(bar, b.x, nloc, nx); b.st[0] = nloc; b.st[1] = nx; }
        const unsigned old = xb_add(&bar[XB_XSUB(b.x)], 1u);
        const unsigned gen = old / nloc;
        if (old + 1u == (gen + 1u) * nloc) {
            __builtin_amdgcn_fence(__ATOMIC_RELEASE, "agent");
            asm volatile("s_waitcnt vmcnt(0)" ::: "memory");
            const unsigned og = xb_add(&bar[XB_TOP], 1u);
            const unsigned tg = og / nx;
            if (og + 1u == (tg + 1u) * nx) xb_add(&bar[XB_TOPGEN], 1u);
            else XB_SPIN(xb_ld(&bar[XB_TOPGEN]) == tg, bar);
            __builtin_amdgcn_fence(__ATOMIC_ACQUIRE, "agent");
            xb_add(&bar[XB_XGEN(b.x)], 1u);
            asm volatile("s_waitcnt vmcnt(0)" ::: "memory");
        } else {
            XB_SPIN(xb_ld(&bar[XB_XGEN(b.x)]) == gen, bar);
            __builtin_amdgcn_fence(__ATOMIC_ACQUIRE, "agent");
            asm volatile("s_waitcnt vmcnt(0)" ::: "memory");
        }
    }
    __syncthreads();
}

__global__ void __launch_bounds__(NTHR) mega(Args args) {
    extern __shared__ __attribute__((aligned(16))) unsigned char lds[];
    cg::grid_group grid = cg::this_grid();
    LAS unsigned char* ldsl = (LAS unsigned char*)lds;
    unsigned char* ws = args.ws;
    float* Z = (float*)(ws + WS_Z); bf16_t* P = (bf16_t*)(ws + WS_P); unsigned char* wb = ws + WS_WB;
    bf16_t* H = (bf16_t*)((unsigned char*)args.out + DO_H); bf16_t* VF = (bf16_t*)((unsigned char*)args.out + DO_VF);
    const int G = gridDim.x, c = blockIdx.x;
    unsigned* bar_words = (unsigned*)(ws + 4096);
    volatile LAS unsigned* bar_st = (volatile LAS unsigned*)(ldsl + LDS_BYTES - 64);
    if (c == 0) for (int i = threadIdx.x; i < XCD_BAR_WORDS; i += NTHR) bar_words[i] = 0u;
    if (threadIdx.x == 0) { bar_st[0] = 0u; bar_st[1] = 0u; }
    __syncthreads();
#ifdef PROBE_CLASS
    unsigned long long tacc = 0, tprev = __builtin_amdgcn_s_memrealtime();
#define TICK(k) do { const unsigned long long tn = __builtin_amdgcn_s_memrealtime(); if ((PROBE_CLASS >> (k)) & 1) tacc += tn - tprev; tprev = tn; } while (0)
#else
#define TICK(k) do {} while (0)
#endif

    convert_weights(args, 0, wb, (float*)lds);
    norm_rows(0, args.in[0], args.in[1], Z, args.in[2], H, nullptr);
    grid.sync(); TICK(0);
    const XcdBarrier xb = xcd_barrier_post(bar_words, bar_st);
#pragma unroll 1
    for (int l = 0; l < 2; ++l) {
        if (l == 1) { convert_weights(args, 1, wb, (float*)lds); norm_rows(1, nullptr, nullptr, Z, args.in[2] + 1024, H, nullptr); xcd_barrier(xb); TICK(0); }
        {
            pg::GemmPlain g{H, (const bf16_t*)(wb + WB_WIN), 1024, 1024, 1024}; pg::Order2D S; S.init(129, 22, G, c, 1, 1); pg::EpiP E{P};
#ifndef NO_G1
            pg::gemm_phase(ldsl, g, S, E);
            { pg::Order2D T; T.init(129, 22, G, c, 1, 2); pg::gemm_phase<true>(ldsl, g, T, E); }
#endif
#if defined(REP_MASK) && (REP_MASK & 1)
            pg::gemm_phase(ldsl, g, S, E);
#endif
        }
        xcd_barrier(xb); TICK(1);
        for (int it = c; it < 256; it += G) {
#ifndef NO_RW
            if (it < 128) rwkv_unit(lds, P, VF, it >> 3, it & 7, l, args);
#endif
#ifndef NO_GLA
            if (it >= 128 && it < 192) gla_unit<64, false>(lds, P, (it - 128) >> 2, (it - 128) & 3, l, args);
#endif
#ifndef NO_HG
            if (it >= 192) gla_unit<128, true>(lds, P, (it - 192) >> 2, (it - 192) & 3, l, args);
#endif
            __syncthreads();
        }
#if defined(REP_MASK) && (REP_MASK & 14)
        { const bool never = (args.ws == nullptr);
        for (int it = c; it < 256; it += G) {
#if REP_MASK & 2
            if (it < 128) rwkv_unit(lds, P, VF, it >> 3, it & 7, l, args, never);
#endif
#if REP_MASK & 4
            if (it >= 128 && it < 192) gla_unit<64, false>(lds, P, (it - 128) >> 2, (it - 128) & 3, l, args, never);
#endif
#if REP_MASK & 8
            if (it >= 192) gla_unit<128, true>(lds, P, (it - 192) >> 2, (it - 192) & 3, l, args, never);
#endif
            __syncthreads();
        } }
#endif
        xcd_barrier(xb); TICK(2);
        {
            pg::GemmPlain g{H, (const bf16_t*)(wb + WB_WG), 1024, 1024, 1024}; pg::Order2D S; S.init(129, 12, G, c, 1, 1); pg::EpiGate E{P};
#ifndef NO_M1
            pg::gemm_phase(ldsl, g, S, E);
            { pg::Order2D T; T.init(129, 12, G, c, 1, 2); pg::gemm_phase<true>(ldsl, g, T, E); }
#endif
#if defined(REP_MASK) && (REP_MASK & 128)
            pg::gemm_phase(ldsl, g, S, E);
#endif
        }
        xcd_barrier(xb); TICK(3);
        {
            pg::GemmMerge g{P, (const bf16_t*)(wb + WB_WO), LDP, 512, 512}; pg::Order2D S; S.init(129, 4, G, c, 3, 1); pg::EpiMerge E{P, H};
#ifndef NO_M2
            pg::gemm_phase(ldsl, g, S, E);
            { pg::Order2D T; T.init(129, 4, G, c, 3, 2); pg::gemm_phase<true>(ldsl, g, T, E); }
#endif
#if defined(REP_MASK) && (REP_MASK & 256)
            pg::gemm_phase(ldsl, g, S, E);
#endif
        }
        xcd_barrier(xb); TICK(4);
        {
            pg::GemmSplit g{H, (const bf16_t*)(wb + WB_WOUT), 1024, 1024, 1024, 128}; pg::OrderSplit S; S.init(129, 4, G, c, 8); pg::EpiResid E{Z};
#ifndef NO_O
            pg::gemm_phase(ldsl, g, S, E);
#endif
        }
        xcd_barrier(xb); TICK(5);
        norm_rows(1, nullptr, nullptr, Z, args.in[28] + l * 1024, H, nullptr);
        xcd_barrier(xb); TICK(6);
        {
            pg::GemmUp g{H, (const bf16_t*)(wb + WB_WUP), 1024, 1024, 1024}; pg::Order2D S; S.init(131, 22, G, c);
            pg::EpiFFN E{P, args.in[30] + (size_t)l * 3 * 5632, args.in[31] + (size_t)l * 5632};
#ifndef NO_U
            pg::gemm_phase(ldsl, g, S, E);
#endif
#if defined(REP_MASK) && (REP_MASK & 16)
            pg::gemm_phase(ldsl, g, S, E);
#endif
        }
        xcd_barrier(xb); TICK(7);
        {
            pg::GemmSplit g{P, (const bf16_t*)(wb + WB_WDN), DFF, DFF, DFF, 256}; pg::OrderSplit S; S.init(129, 4, G, c, 11); pg::EpiResid E{Z};
#ifndef NO_D
            pg::gemm_phase(ldsl, g, S, E);
#endif
        }
        xcd_barrier(xb); TICK(8);
    }
#ifdef PROBE_CLASS
    if (c == 0 && threadIdx.x == 0) *(volatile float*)(ws + 1024) = 1.0f + (float)tacc * (1.0f / 5000000.0f);
    __threadfence(); xcd_barrier(xb);
    probe_scale_rows(args.in[33], (float*)(ws + 2048), *(volatile float*)(ws + 1024));
    norm_rows(2, nullptr, nullptr, Z, (const float*)(ws + 2048), nullptr, args.out);
#else
    norm_rows(2, nullptr, nullptr, Z, args.in[33], nullptr, args.out);
#endif
#ifdef EXTRA_SYNCS
    for (int i = 0; i < EXTRA_SYNCS; ++i) xcd_barrier(xb);
#endif
}

extern "C" void kernel_launch(void* const* d_in, const int* in_sizes, int n_in, void* d_out, int out_size, void* d_ws, size_t ws_size, hipStream_t stream) {
    static int grid = 0;
    if (grid == 0) {
        int dev = 0, cus = 0, per_cu = 0;
        hipGetDevice(&dev);
        hipDeviceGetAttribute(&cus, hipDeviceAttributeMultiprocessorCount, dev);
        if (hipFuncSetAttribute((const void*)mega, hipFuncAttributeMaxDynamicSharedMemorySize, LDS_BYTES) != hipSuccess) fprintf(stderr, "kernel_launch: hipFuncSetAttribute failed\n");
        if (hipOccupancyMaxActiveBlocksPerMultiprocessor(&per_cu, (const void*)mega, NTHR, LDS_BYTES) != hipSuccess || per_cu < 1) { fprintf(stderr, "kernel_launch: occupancy query gave %d\n", per_cu); per_cu = 1; }
        (void)hipGetLastError();
        grid = cus * per_cu;
        if (n_in != 34 || ws_size < WS_WB + WB_END) fprintf(stderr, "kernel_launch: unexpected n_in %d / ws_size %zu\n", n_in, ws_size);
    }
    Args a{};
    for (int i = 0; i < 34; ++i) a.in[i] = (const float*)d_in[i];
    a.out = (float*)d_out; a.ws = (unsigned char*)d_ws;
    void* kargs[] = {&a};
    hipError_t e = hipLaunchCooperativeKernel((const void*)mega, dim3(grid), dim3(NTHR), kargs, LDS_BYTES, stream);
    if (e != hipSuccess) fprintf(stderr, "kernel_launch: cooperative launch failed: %s (grid %d)\n", hipGetErrorString(e), grid);
}
```
